# Optimizing an MI355X kernel written in HIP

```python
import math
import jax, jax.numpy as jnp
from jax import lax
import numpy as np

D_MODEL = 1024
BATCH = 16
SEQ = 2048
DEPTH = 4

GRID_W = 64
CTX_LEN = 256
HEAD_DIM = 64
Q_BLOCK = 128
WINDOW = 128
ROPE_THETA = 10000.0
EPS = 1e-6
NEG_INF = -1e30

A_Q_HEADS = 8
A_KV_HEADS = 2
A_GROUP = A_Q_HEADS // A_KV_HEADS
B_HEADS = 8
B_Q_RANK = 256
B_KV_RANK = 128
B_NOPE = 64
B_ROPE = 32
B_V = 64
C_Q_HEADS = 8
C_KV_HEADS = 2
C_GROUP = C_Q_HEADS // C_KV_HEADS
D_HEADS = 4
D_V = 2 * HEAD_DIM

EVEN_SIZES = (A_Q_HEADS * HEAD_DIM, A_KV_HEADS * HEAD_DIM, A_KV_HEADS * HEAD_DIM, B_Q_RANK, B_KV_RANK, B_ROPE)
ODD_SIZES = (C_Q_HEADS * HEAD_DIM, C_KV_HEADS * HEAD_DIM, C_KV_HEADS * HEAD_DIM,
             D_HEADS * 2 * HEAD_DIM, D_HEADS * 2 * HEAD_DIM, D_HEADS * D_V)
EVEN_IN = sum(EVEN_SIZES)
ODD_IN = sum(ODD_SIZES)
MIX_WIDTH = A_Q_HEADS * HEAD_DIM + B_HEADS * B_V
FFN_HIDDEN = -(-8 * D_MODEL // (3 * 256)) * 256
N_EVEN = (DEPTH + 1) // 2
N_ODD = DEPTH // 2

kernel_name = "hybrid_diffusion_prefix_trunk"


def rms_norm(x, g):
    xf = x.astype(jnp.float32)
    y = xf * lax.rsqrt(jnp.mean(xf * xf, axis=-1, keepdims=True) + EPS)
    return (y * g.astype(jnp.float32)).astype(x.dtype)


def split_cols(p, sizes):
    return jnp.split(p, [int(v) for v in np.cumsum(sizes)[:-1]], axis=-1)


def rope_1d(x, pos):
    half = x.shape[-1] // 2
    freqs = ROPE_THETA ** (-jnp.arange(half, dtype=jnp.float32) / half)
    ang = pos.astype(jnp.float32)[:, None] * freqs[None, :]
    ang = ang.reshape((ang.shape[0],) + (1,) * (x.ndim - 3) + (half,))
    cos, sin = jnp.cos(ang), jnp.sin(ang)
    x1 = x[..., :half].astype(jnp.float32)
    x2 = x[..., half:].astype(jnp.float32)
    return jnp.concatenate([x1 * cos - x2 * sin, x2 * cos + x1 * sin], axis=-1).astype(x.dtype)


def rope_2d(x, rows, cols):
    h = x.shape[-1] // 2
    return jnp.concatenate([rope_1d(x[..., :h], rows), rope_1d(x[..., h:], cols)], axis=-1)


def sweep_query_blocks(fn, q):
    B, S = q.shape[:2]
    nb = S // Q_BLOCK
    qb = jnp.moveaxis(q.reshape((B, nb, Q_BLOCK) + q.shape[2:]), 1, 0)
    ob = lax.map(fn, qb)
    return jnp.moveaxis(ob, 0, 1).reshape((B, S) + ob.shape[3:])


def gqa_attend(q, k, v, scale):
    s = jnp.einsum('bqhgd,bkhd->bhgqk', q, k, preferred_element_type=jnp.float32) * scale
    p = jax.nn.softmax(s, axis=-1)
    return jnp.einsum('bhgqk,bkhd->bqhgd', p.astype(v.dtype), v)


def sink_attend(q, k, v, sink):
    Hk, G, d = q.shape[2], q.shape[3], q.shape[4]
    s = jnp.einsum('bqhgd,bkhd->bhgqk', q, k, preferred_element_type=jnp.float32) * d ** -0.5
    sk = jnp.broadcast_to(sink.astype(jnp.float32).reshape(Hk, G, 1, 1), s.shape[:-1] + (1,))
    p = jax.nn.softmax(jnp.concatenate([s, sk], axis=-1), axis=-1)[..., :-1]
    return jnp.einsum('bhgqk,bkhd->bqhgd', p.astype(v.dtype), v)


def windowed_sink_attention(q, k, v, k_ctx, v_ctx, sink):
    B, S, Hk, G, d = q.shape
    nb = S // Q_BLOCK
    L = 3 * Q_BLOCK
    scale = d ** -0.5
    qb = q.reshape(B, nb, Q_BLOCK, Hk, G, d)

    def band(t):
        tb = t.reshape(B, nb, Q_BLOCK, Hk, t.shape[-1])
        tp = jnp.pad(tb, ((0, 0), (1, 1), (0, 0), (0, 0), (0, 0)))
        return jnp.concatenate([tp[:, :-2], tp[:, 1:-1], tp[:, 2:]], axis=2)

    kw, vw = band(k), band(v)
    blk = jnp.arange(nb)[:, None, None]
    q_pos = blk * Q_BLOCK + jnp.arange(Q_BLOCK)[None, :, None]
    k_pos = (blk - 1) * Q_BLOCK + jnp.arange(L)[None, None, :]
    valid = (jnp.abs(q_pos - k_pos) <= WINDOW) & (k_pos >= 0) & (k_pos < S)
    s_loc = jnp.einsum('bnqhgd,bnkhd->bnhgqk', qb, kw, preferred_element_type=jnp.float32) * scale
    s_loc = jnp.where(valid[None, :, None, None, :, :], s_loc, NEG_INF)
    s_ctx = jnp.einsum('bnqhgd,bchd->bnhgqc', qb, k_ctx, preferred_element_type=jnp.float32) * scale
    sk = jnp.broadcast_to(sink.astype(jnp.float32).reshape(Hk, G, 1, 1), s_loc.shape[:-1] + (1,))
    p = jax.nn.softmax(jnp.concatenate([s_loc, s_ctx, sk], axis=-1), axis=-1)
    C = k_ctx.shape[1]
    o = (jnp.einsum('bnhgqk,bnkhd->bnqhgd', p[..., :L].astype(v.dtype), vw)
         + jnp.einsum('bnhgqc,bchd->bnqhgd', p[..., L:L + C].astype(v.dtype), v_ctx))
    return o.reshape(B, S, Hk, G, v.shape[-1])


def diff_attend(q, k, v, lam):
    s = jnp.einsum('bqhid,bkhid->bhiqk', q, k, preferred_element_type=jnp.float32) * q.shape[-1] ** -0.5
    p = jax.nn.softmax(s, axis=-1)
    a = p[:, :, 0] - lam * p[:, :, 1]
    return jnp.einsum('bhqk,bkhd->bqhd', a.astype(v.dtype), v)


def even_project(t, rope, w_in, q_norm, w_uq, kv_norm, w_ukv):
    B, L, _ = t.shape
    qa, ka, va, cq, ckv, kpe = split_cols(t @ w_in, EVEN_SIZES)
    qa = rope(qa.reshape(B, L, A_KV_HEADS, A_GROUP, HEAD_DIM))
    ka = rope(ka.reshape(B, L, A_KV_HEADS, HEAD_DIM))
    va = va.reshape(B, L, A_KV_HEADS, HEAD_DIM)
    qb = (rms_norm(cq, q_norm) @ w_uq).reshape(B, L, B_HEADS, B_NOPE + B_ROPE)
    qb = jnp.concatenate([qb[..., :B_NOPE], rope(qb[..., B_NOPE:])], axis=-1)[:, :, :, None, :]
    kvb = (rms_norm(ckv, kv_norm) @ w_ukv).reshape(B, L, B_HEADS, B_NOPE + B_V)
    kpe = jnp.broadcast_to(rope(kpe[:, :, None, :]), (B, L, B_HEADS, B_ROPE))
    kb = jnp.concatenate([kvb[..., :B_NOPE], kpe], axis=-1)
    vb = kvb[..., B_NOPE:]
    return qa, ka, va, qb, kb, vb


def mixer_even(h, hc, rows, cols, w_in, sink, q_norm, w_uq, kv_norm, w_ukv, w_out, need_ctx):
    B, S = h.shape[:2]
    qa, ka, va, qb, kb, vb = even_project(h, lambda t: rope_2d(t, rows, cols), w_in, q_norm, w_uq, kv_norm, w_ukv)
    qa_c, ka_c, va_c, qb_c, kb_c, vb_c = even_project(hc, lambda t: t, w_in, q_norm, w_uq, kv_norm, w_ukv)
    scale_b = (B_NOPE + B_ROPE) ** -0.5
    oa = windowed_sink_attention(qa, ka, va, ka_c, va_c, sink)
    kb_all = jnp.concatenate([kb_c, kb], axis=1)
    vb_all = jnp.concatenate([vb_c, vb], axis=1)
    ob = sweep_query_blocks(lambda qq: gqa_attend(qq, kb_all, vb_all, scale_b), qb)
    y = jnp.concatenate([oa.reshape(B, S, -1), ob.reshape(B, S, -1)], axis=-1) @ w_out
    yc = None
    if need_ctx:
        C = hc.shape[1]
        oa_c = sink_attend(qa_c, ka_c, va_c, sink)
        ob_c = gqa_attend(qb_c, kb_c, vb_c, scale_b)
        yc = jnp.concatenate([oa_c.reshape(B, C, -1), ob_c.reshape(B, C, -1)], axis=-1) @ w_out
    return y, yc


def odd_project(t, rope, w_in, qk_norm):
    B, L, _ = t.shape
    qc, kc, vc, qd, kd, vd = split_cols(t @ w_in, ODD_SIZES)
    qc = rope(rms_norm(qc.reshape(B, L, C_KV_HEADS, C_GROUP, HEAD_DIM), qk_norm[0]))
    kc = rope(rms_norm(kc.reshape(B, L, C_KV_HEADS, HEAD_DIM), qk_norm[1]))
    vc = vc.reshape(B, L, C_KV_HEADS, HEAD_DIM)
    qd = rope(qd.reshape(B, L, D_HEADS, 2, HEAD_DIM))
    kd = rope(kd.reshape(B, L, D_HEADS, 2, HEAD_DIM))
    vd = vd.reshape(B, L, D_HEADS, D_V)
    return qc, kc, vc, qd, kd, vd


def mixer_odd(h, hc, rows, cols, w_in, qk_norm, lam_p, subln, w_out, lam_init, need_ctx):
    B, S = h.shape[:2]
    qc, kc, vc, qd, kd, vd = odd_project(h, lambda t: rope_2d(t, rows, cols), w_in, qk_norm)
    qc_c, kc_c, vc_c, qd_c, kd_c, vd_c = odd_project(hc, lambda t: t, w_in, qk_norm)
    lp = lam_p.astype(jnp.float32)
    lam = jnp.exp(jnp.sum(lp[0] * lp[1])) - jnp.exp(jnp.sum(lp[2] * lp[3])) + lam_init
    scale_c = HEAD_DIM ** -0.5
    kc_all = jnp.concatenate([kc_c, kc], axis=1)
    vc_all = jnp.concatenate([vc_c, vc], axis=1)
    kd_all = jnp.concatenate([kd_c, kd], axis=1)
    vd_all = jnp.concatenate([vd_c, vd], axis=1)
    oc = sweep_query_blocks(lambda qq: gqa_attend(qq, kc_all, vc_all, scale_c), qc)
    od = sweep_query_blocks(lambda qq: diff_attend(qq, kd_all, vd_all, lam), qd)
    od = rms_norm(od, subln) * (1.0 - lam_init)
    y = jnp.concatenate([oc.reshape(B, S, -1), od.reshape(B, S, -1)], axis=-1) @ w_out
    yc = None
    if need_ctx:
        C = hc.shape[1]
        oc_c = gqa_attend(qc_c, kc_c, vc_c, scale_c)
        od_c = rms_norm(diff_attend(qd_c, kd_c, vd_c, lam), subln) * (1.0 - lam_init)
        yc = jnp.concatenate([oc_c.reshape(B, C, -1), od_c.reshape(B, C, -1)], axis=-1) @ w_out
    return y, yc


def swiglu(h, w_in, w_out):
    g, u = jnp.split(h @ w_in, 2, axis=-1)
    return (jax.nn.silu(g) * u) @ w_out


def diff_lambda_init(layer):
    return 0.8 - 0.6 * math.exp(-0.3 * layer)


def setup_inputs(seed: int = 0) -> dict:
    key = jax.random.key(seed)
    ks = jax.random.split(key, 24)
    D = D_MODEL

    def nrm(k, shape, scale):
        return jax.random.normal(k, shape, jnp.float32) * scale

    return {
        "x": nrm(ks[0], (BATCH, SEQ, D), 1.0),
        "c": nrm(ks[1], (BATCH, D), 1.0),
        "ctx": nrm(ks[2], (BATCH, CTX_LEN, D), 1.0),
        "c_ctx": nrm(ks[3], (D,), 1.0),
        "ada_w": nrm(ks[4], (DEPTH, D, 6 * D), 0.5 * D ** -0.5),
        "ada_b": nrm(ks[5], (DEPTH, 6 * D), 0.02),
        "norm_g": 1.0 + nrm(ks[6], (DEPTH, 4, D), 0.1),
        "ffn_w_in": nrm(ks[7], (DEPTH, D, 2 * FFN_HIDDEN), D ** -0.5),
        "ffn_w_out": nrm(ks[8], (DEPTH, FFN_HIDDEN, D), FFN_HIDDEN ** -0.5),
        "ev_w_in": nrm(ks[9], (N_EVEN, D, EVEN_IN), D ** -0.5),
        "ev_sink": nrm(ks[10], (N_EVEN, A_Q_HEADS), 0.5),
        "ev_q_norm": 1.0 + nrm(ks[11], (N_EVEN, B_Q_RANK), 0.1),
        "ev_w_uq": nrm(ks[12], (N_EVEN, B_Q_RANK, B_HEADS * (B_NOPE + B_ROPE)), B_Q_RANK ** -0.5),
        "ev_kv_norm": 1.0 + nrm(ks[13], (N_EVEN, B_KV_RANK), 0.1),
        "ev_w_ukv": nrm(ks[14], (N_EVEN, B_KV_RANK, B_HEADS * (B_NOPE + B_V)), B_KV_RANK ** -0.5),
        "ev_w_out": nrm(ks[15], (N_EVEN, MIX_WIDTH, D), MIX_WIDTH ** -0.5),
        "od_w_in": nrm(ks[16], (N_ODD, D, ODD_IN), D ** -0.5),
        "od_qk_norm": 1.0 + nrm(ks[17], (N_ODD, 2, HEAD_DIM), 0.1),
        "od_lambda": nrm(ks[18], (N_ODD, 4, HEAD_DIM), 0.1),
        "od_subln": 1.0 + nrm(ks[19], (N_ODD, D_V), 0.1),
        "od_w_out": nrm(ks[20], (N_ODD, MIX_WIDTH, D), MIX_WIDTH ** -0.5),
    }


def reference(x, c, ctx, c_ctx, ada_w, ada_b, norm_g, ffn_w_in, ffn_w_out,
              ev_w_in, ev_sink, ev_q_norm, ev_w_uq, ev_kv_norm, ev_w_ukv, ev_w_out,
              od_w_in, od_qk_norm, od_lambda, od_subln, od_w_out):
    B, S, _ = x.shape
    ROWS = S // GRID_W
    rows = jnp.repeat(jnp.arange(ROWS), GRID_W)
    cols = jnp.tile(jnp.arange(GRID_W), ROWS)
    s_c = jax.nn.silu(c)
    s_cc = jax.nn.silu(c_ctx)
    xc = ctx
    for l in range(DEPTH):
        need_ctx = l < DEPTH - 1
        mod = (s_c @ ada_w[l] + ada_b[l])[:, None, :]
        mod_c = s_cc @ ada_w[l] + ada_b[l]
        sh1, sc1, g1, sh2, sc2, g2 = jnp.split(mod, 6, axis=-1)
        csh1, csc1, cg1, csh2, csc2, cg2 = jnp.split(mod_c, 6, axis=-1)
        h = rms_norm(x, norm_g[l, 0]) * (1.0 + sc1) + sh1
        hc = rms_norm(xc, norm_g[l, 0]) * (1.0 + csc1) + csh1
        if l % 2 == 0:
            e = l // 2
            y, yc = mixer_even(h, hc, rows, cols, ev_w_in[e], ev_sink[e], ev_q_norm[e], ev_w_uq[e],
                               ev_kv_norm[e], ev_w_ukv[e], ev_w_out[e], need_ctx)
        else:
            o = l // 2
            y, yc = mixer_odd(h, hc, rows, cols, od_w_in[o], od_qk_norm[o], od_lambda[o], od_subln[o],
                              od_w_out[o], diff_lambda_init(l), need_ctx)
        x = x + g1 * rms_norm(y, norm_g[l, 1])
        h = rms_norm(x, norm_g[l, 2]) * (1.0 + sc2) + sh2
        x = x + g2 * rms_norm(swiglu(h, ffn_w_in[l], ffn_w_out[l]), norm_g[l, 3])
        if need_ctx:
            xc = xc + cg1 * rms_norm(yc, norm_g[l, 1])
            hc = rms_norm(xc, norm_g[l, 2]) * (1.0 + csc2) + csh2
            xc = xc + cg2 * rms_norm(swiglu(hc, ffn_w_in[l], ffn_w_out[l]), norm_g[l, 3])
    return x
```

```cpp
#include <hip/hip_runtime.h>
#include <hip/hip_cooperative_groups.h>
#include <cstdio>
#include <cstdint>
namespace cg = cooperative_groups;
#ifndef REP_GEMM
#define REP_GEMM 1
#endif
#ifndef REP_ATTN
#define REP_ATTN 1
#endif
#ifndef REP_P0
#define REP_P0 1
#endif

typedef unsigned short u16;
typedef short bf16x8 __attribute__((ext_vector_type(8)));
typedef short bf16x4 __attribute__((ext_vector_type(4)));
typedef float f32x4 __attribute__((ext_vector_type(4)));
typedef unsigned u32x4 __attribute__((ext_vector_type(4)));
typedef unsigned u32x2 __attribute__((ext_vector_type(2)));

constexpr int DM = 1024, NBATCH = 16, SEQ = 2048, CTX = 256, TOK = 2304, MR = NBATCH * TOK, FFH = 2816;
constexpr float EPS = 1e-6f;
constexpr float LOG2E = 1.4426950408889634f;
constexpr int LDS_BYTES = 81920;

constexpr size_t al256(size_t x) { return (x + 255) & ~size_t(255); }
constexpr size_t OFF_MOD = 0;
constexpr size_t OFF_R16 = OFF_MOD + al256(4ull * 17 * 6144 * 4);
constexpr size_t OFF_R8 = OFF_R16 + 8192;
constexpr size_t OFF_LAM = OFF_R8 + 4096;
constexpr size_t OFF_XC = OFF_LAM + 256;
constexpr size_t OFF_W = OFF_XC + (size_t)NBATCH * CTX * DM * 4;
constexpr size_t W_FFN1 = 0;
constexpr size_t W_FFN2 = W_FFN1 + 4ull * 5632 * 1024;
constexpr size_t W_EIN = W_FFN2 + 4ull * 1024 * 2816;
constexpr size_t W_UQ = W_EIN + 2ull * 1280 * 1024;
constexpr size_t W_UKV = W_UQ + 2ull * 768 * 256;
constexpr size_t W_EOUT = W_UKV + 2ull * 1024 * 128;
constexpr size_t W_OIN = W_EOUT + 2ull * 1024 * 1024;
constexpr size_t W_OOUT = W_OIN + 2ull * 2304 * 1024;
constexpr size_t W_END = W_OOUT + 2ull * 1024 * 1024;
constexpr size_t OFF_HO = OFF_W + al256(W_END * 2);
constexpr size_t OFF_R1 = OFF_HO + (size_t)MR * DM * 2;
constexpr size_t OFF_ACT = OFF_R1;
constexpr size_t OFF_Y = OFF_ACT + (size_t)MR * FFH * 2;
constexpr size_t WS_END = OFF_Y + (size_t)MR * DM * 2;
constexpr size_t P_QA = OFF_R1;
constexpr size_t P_KA = P_QA + (size_t)MR * 512 * 2;
constexpr size_t P_VAT = P_KA + (size_t)MR * 128 * 2;
constexpr size_t P_CQ = P_VAT + (size_t)MR * 128 * 2;
constexpr size_t P_CKV = P_CQ + (size_t)MR * 256 * 2;
constexpr size_t P_KPE = P_CKV + (size_t)MR * 128 * 2;
constexpr size_t P_SS = P_KPE + (size_t)MR * 32 * 2;
constexpr size_t P_QB = P_SS + (size_t)MR * 8 * 4;
constexpr size_t P_KB = P_QB + (size_t)MR * 768 * 2;
constexpr size_t P_VBT = P_KB + (size_t)MR * 768 * 2;
constexpr size_t P_EEND = P_VBT + (size_t)MR * 512 * 2;
constexpr size_t P_QC = OFF_R1;
constexpr size_t P_KC = P_QC + (size_t)MR * 512 * 2;
constexpr size_t P_VCT = P_KC + (size_t)MR * 128 * 2;
constexpr size_t P_QD = P_VCT + (size_t)MR * 128 * 2;
constexpr size_t P_KD = P_QD + (size_t)MR * 512 * 2;
constexpr size_t P_VDT = P_KD + (size_t)MR * 512 * 2;
constexpr size_t P_OEND = P_VDT + (size_t)MR * 512 * 2;
static_assert(P_EEND <= WS_END && P_OEND <= WS_END, "projection overlay too large");
constexpr size_t OFF_BAR = WS_END;
constexpr size_t WS_TOTAL = WS_END + 16384;
static_assert(WS_TOTAL <= 536870912ull, "workspace too large");

struct Params {
    const float *x, *c, *ctx, *c_ctx, *ada_w, *ada_b, *norm_g, *ffn_w_in, *ffn_w_out;
    const float *ev_w_in, *ev_sink, *ev_q_norm, *ev_w_uq, *ev_kv_norm, *ev_w_ukv, *ev_w_out;
    const float *od_w_in, *od_qk_norm, *od_lambda, *od_subln, *od_w_out;
    float* out;
    unsigned char* ws;
};

typedef float f32x2_t __attribute__((ext_vector_type(2)));
typedef __bf16 bf16x2_t __attribute__((ext_vector_type(2)));
__device__ __forceinline__ unsigned pk2(float lo, float hi) {
    const f32x2_t v = {lo, hi};
    return __builtin_bit_cast(unsigned, __builtin_convertvector(v, bf16x2_t));
}
__device__ __forceinline__ int opaque_tid() { int t = threadIdx.x; asm volatile("" : "+v"(t)); return t; }
__device__ __forceinline__ u16 f2bf(float f) { return (u16)(pk2(f, 0.f) & 0xffffu); }
__device__ __forceinline__ float bf2f(unsigned h) { return __uint_as_float(h << 16); }
__device__ __forceinline__ float wave_sum(float v) {
#pragma unroll
    for (int o = 1; o < 64; o <<= 1) v += __shfl_xor(v, o);
    return v;
}
__device__ __forceinline__ size_t tiled_off(int row, int k, int K) { return ((size_t)(row >> 4) * (K >> 5) + (k >> 5)) * 512 + (row & 15) * 32 + (k & 31); }
__device__ __forceinline__ size_t ktile_off(int t, int d, int NDS) {
    const int p = t & 63, kk = ((p >> 5) << 1) | ((p >> 2) & 1), r = ((p >> 3) & 3) * 4 + (p & 3);
    return ((size_t)(t >> 6) * (4 * NDS) + kk * NDS + (d >> 5)) * 512 + r * 32 + (d & 31);
}
__device__ __forceinline__ size_t vtile_off(int dv, int t, int NI) {
    return ((size_t)(t >> 6) * (2 * NI) + (dv >> 4) * 2 + ((t >> 5) & 1)) * 512 + (dv & 15) * 32 + (t & 31);
}
__device__ __forceinline__ float lam_init_of(int l) { return 0.8f - 0.6f * expf(-0.3f * (float)l); }

__device__ __forceinline__ void ada_item(const Params& p, int it, unsigned char* smem) {
    const int tid = opaque_tid(), lane = tid & 63, wid = tid >> 6;
    const int l = it / 96, n0 = (it % 96) * 64;
    float* S = (float*)smem;
    for (int i = tid; i < 17 * 1024; i += 256) {
        const int r = i >> 10, k = i & 1023;
        const float cv = (r < 16) ? p.c[r * 1024 + k] : p.c_ctx[k];
        S[i] = cv / (1.f + expf(-cv));
    }
    __syncthreads();
    float acc[17];
#pragma unroll
    for (int r = 0; r < 17; ++r) acc[r] = 0.f;
    const float* W = p.ada_w + (size_t)l * 1024 * 6144 + n0 + lane;
    const int kb = wid * 256;
#pragma unroll 2
    for (int k = kb; k < kb + 256; k += 4) {
        const float w0 = W[(size_t)k * 6144], w1 = W[(size_t)(k + 1) * 6144], w2 = W[(size_t)(k + 2) * 6144], w3 = W[(size_t)(k + 3) * 6144];
#pragma unroll
        for (int r = 0; r < 17; ++r) {
            const f32x4 s = *(const f32x4*)&S[r * 1024 + k];
            acc[r] += s[0] * w0 + s[1] * w1 + s[2] * w2 + s[3] * w3;
        }
    }
    __syncthreads();
    float* R = (float*)smem;
#pragma unroll
    for (int r = 0; r < 17; ++r) R[(wid * 17 + r) * 64 + lane] = acc[r];
    __syncthreads();
    float* MOD = (float*)(p.ws + OFF_MOD);
    for (int i = tid; i < 17 * 64; i += 256) {
        const int r = i >> 6, n = i & 63;
        const float v = R[(0 * 17 + r) * 64 + n] + R[(1 * 17 + r) * 64 + n] + R[(2 * 17 + r) * 64 + n] + R[(3 * 17 + r) * 64 + n] + p.ada_b[l * 6144 + n0 + n];
        MOD[((size_t)l * 17 + r) * 6144 + n0 + n] = v;
    }
    __syncthreads();
}

__device__ __forceinline__ void wt_tile(const float* __restrict__ src, u16* __restrict__ dst, const float* __restrict__ ksc, int K, int N, int Npad, int mode, int t, unsigned char* smem) {
    const int tid = opaque_tid();
    const int nT = Npad >> 8;
    const int nt = t % nT, kt = t / nT, n0 = nt * 256, k0 = kt * 64;
    float* T = (float*)smem;
    {
        const int c4 = (tid & 63) * 4, ks = tid >> 6, n = n0 + c4;
#pragma unroll
        for (int i = 0; i < 16; ++i) {
            const int k = i * 4 + ks;
            f32x4 v = (n < N) ? *(const f32x4*)(src + (size_t)(k0 + k) * N + n) : (f32x4){0.f, 0.f, 0.f, 0.f};
            if (ksc) v = v * ksc[k0 + k];
            *(f32x4*)(T + k * 260 + c4) = v;
        }
    }
    __syncthreads();
#pragma unroll
    for (int kq = 0; kq < 4; ++kq) {
        const float* s = T + (kq * 16) * 260 + tid;
        uint4 o0, o1;
        o0.x = pk2(s[0 * 260], s[1 * 260]); o0.y = pk2(s[2 * 260], s[3 * 260]); o0.z = pk2(s[4 * 260], s[5 * 260]); o0.w = pk2(s[6 * 260], s[7 * 260]);
        o1.x = pk2(s[8 * 260], s[9 * 260]); o1.y = pk2(s[10 * 260], s[11 * 260]); o1.z = pk2(s[12 * 260], s[13 * 260]); o1.w = pk2(s[14 * 260], s[15 * 260]);
        int nd = n0 + tid;
        if (mode == 1) nd = (nd < FFH) ? ((nd >> 4) * 32 + (nd & 15)) : ((((nd - FFH) >> 4) * 32) + 16 + ((nd - FFH) & 15));
        *(uint4*)(dst + tiled_off(nd, k0 + kq * 16, K)) = o0;
        *(uint4*)(dst + tiled_off(nd, k0 + kq * 16 + 8, K)) = o1;
    }
    __syncthreads();
}

constexpr int T_FFN1 = 16 * 22, T_FFN2 = 44 * 4, T_EIN = 16 * 5, T_UQ = 4 * 3, T_UKV = 2 * 4, T_OUT = 16 * 4, T_OIN = 16 * 9;
constexpr int NT_ALL = 4 * (T_FFN1 + T_FFN2) + 2 * (T_EIN + T_UQ + T_UKV + T_OUT) + 2 * (T_OIN + T_OUT);
constexpr int N_ADA = 4 * 96;

__device__ __forceinline__ void wt_item(const Params& p, int r, unsigned char* smem) {
    u16* Wb = (u16*)(p.ws + OFF_W);
    if (r < 4 * T_FFN1) { const int l = r / T_FFN1; wt_tile(p.ffn_w_in + (size_t)l * 1024 * 5632, Wb + W_FFN1 + (size_t)l * 5632 * 1024, nullptr, 1024, 5632, 5632, 1, r % T_FFN1, smem); return; }
    r -= 4 * T_FFN1;
    if (r < 4 * T_FFN2) { const int l = r / T_FFN2; wt_tile(p.ffn_w_out + (size_t)l * 2816 * 1024, Wb + W_FFN2 + (size_t)l * 1024 * 2816, nullptr, 2816, 1024, 1024, 0, r % T_FFN2, smem); return; }
    r -= 4 * T_FFN2;
    if (r < 2 * T_EIN) { const int e = r / T_EIN; wt_tile(p.ev_w_in + (size_t)e * 1024 * 1184, Wb + W_EIN + (size_t)e * 1280 * 1024, nullptr, 1024, 1184, 1280, 0, r % T_EIN, smem); return; }
    r -= 2 * T_EIN;
    if (r < 2 * T_UQ) { const int e = r / T_UQ; wt_tile(p.ev_w_uq + (size_t)e * 256 * 768, Wb + W_UQ + (size_t)e * 768 * 256, p.ev_q_norm + e * 256, 256, 768, 768, 0, r % T_UQ, smem); return; }
    r -= 2 * T_UQ;
    if (r < 2 * T_UKV) { const int e = r / T_UKV; wt_tile(p.ev_w_ukv + (size_t)e * 128 * 1024, Wb + W_UKV + (size_t)e * 1024 * 128, p.ev_kv_norm + e * 128, 128, 1024, 1024, 0, r % T_UKV, smem); return; }
    r -= 2 * T_UKV;
    if (r < 2 * T_OUT) { const int e = r / T_OUT; wt_tile(p.ev_w_out + (size_t)e * 1024 * 1024, Wb + W_EOUT + (size_t)e * 1024 * 1024, nullptr, 1024, 1024, 1024, 0, r % T_OUT, smem); return; }
    r -= 2 * T_OUT;
    if (r < 2 * T_OIN) { const int o = r / T_OIN; wt_tile(p.od_w_in + (size_t)o * 1024 * 2304, Wb + W_OIN + (size_t)o * 2304 * 1024, nullptr, 1024, 2304, 2304, 0, r % T_OIN, smem); return; }
    r -= 2 * T_OIN;
    { const int o = r / T_OUT; wt_tile(p.od_w_out + (size_t)o * 1024 * 1024, Wb + W_OOUT + (size_t)o * 1024 * 1024, nullptr, 1024, 1024, 1024, 0, r % T_OUT, smem); }
}

__device__ __forceinline__ void misc_item(const Params& p) {
    const int tid = opaque_tid(), lane = tid & 63, wid = tid >> 6;
    float* R16 = (float*)(p.ws + OFF_R16);
    float* R8 = (float*)(p.ws + OFF_R8);
    for (int i = tid; i < 1024; i += 256) {
        const int pos = i >> 4, fi = i & 15;
        const float f = powf(10000.f, -(float)fi / 16.f), a = (float)pos * f;
        R16[2 * i] = cosf(a); R16[2 * i + 1] = sinf(a);
    }
    for (int i = tid; i < 512; i += 256) {
        const int pos = i >> 3, fi = i & 7;
        const float f = powf(10000.f, -(float)fi / 8.f), a = (float)pos * f;
        R8[2 * i] = cosf(a); R8[2 * i + 1] = sinf(a);
    }
    if (wid < 2) {
        const float* lp = p.od_lambda + wid * 256;
        const float sa = wave_sum(lp[lane] * lp[64 + lane]);
        const float sb = wave_sum(lp[128 + lane] * lp[192 + lane]);
        if (lane == 0) ((float*)(p.ws + OFF_LAM))[wid] = expf(sa) - expf(sb) + lam_init_of(2 * wid + 1);
    }
}

__device__ __forceinline__ void phase0(const Params& p, unsigned char* smem) {
    constexpr int TOTAL = N_ADA + NT_ALL + 1;
    for (int it = blockIdx.x; it < TOTAL; it += gridDim.x) {
        if (it < N_ADA) ada_item(p, it, smem);
        else if (it < N_ADA + NT_ALL) wt_item(p, it - N_ADA, smem);
        else misc_item(p);
    }
}

__device__ __forceinline__ f32x4 bf4_to_f32(u32x2 y) {
    f32x4 r; r[0] = bf2f(y[0] & 0xffffu); r[1] = __uint_as_float(y[0] & 0xffff0000u); r[2] = bf2f(y[1] & 0xffffu); r[3] = __uint_as_float(y[1] & 0xffff0000u);
    return r;
}
__device__ __forceinline__ float dot4(f32x4 a) { return a[0] * a[0] + a[1] * a[1] + a[2] * a[2] + a[3] * a[3]; }
__device__ __forceinline__ void rownorm_phase(const Params& p, int mode, int l) {
    const int tid = opaque_tid(), lane = tid & 63, wid = tid >> 6;
    const float* MOD = (const float*)(p.ws + OFF_MOD);
    float* XC = (float*)(p.ws + OFF_XC);
    u16* H = (u16*)(p.ws + OFF_HO);
    const u16* Y = (const u16*)(p.ws + OFF_Y);
    const bool makeH = !(mode == 2 && l == 3);
    const int lh = (mode == 2) ? l + 1 : l;
    const int hsh = (mode == 1) ? 3 : 0, hsc = (mode == 1) ? 4 : 1, hg = (mode == 1) ? 2 : 0;
    const int ug = (mode == 1) ? 2 : 5, ugam = (mode == 1) ? 1 : 3;
    const int col0 = lane * 4;
    for (int ch = blockIdx.x * 4 + wid; ch < MR / 4; ch += gridDim.x * 4) {
        const int row0 = ch * 4;
        const int b = row0 / TOK, t0 = row0 - b * TOK;
        const bool isctx = t0 < CTX;
        if (l == 3 && mode != 0 && isctx) continue;
        const int mb = isctx ? 16 : b;
        float* xp = isctx ? XC + ((size_t)(b * CTX + t0)) * DM : p.out + ((size_t)(b * SEQ + t0 - CTX)) * DM;
        f32x4 xv[4][4];
        if (mode == 0) {
            const float* src = isctx ? p.ctx + ((size_t)(b * CTX + t0)) * DM : p.x + ((size_t)(b * SEQ + t0 - CTX)) * DM;
#pragma unroll
            for (int r = 0; r < 4; ++r)
#pragma unroll
                for (int c = 0; c < 4; ++c) xv[r][c] = *(const f32x4*)(src + (size_t)r * DM + c * 256 + col0);
        } else {
            u32x2 yr[4][4];
#pragma unroll
            for (int r = 0; r < 4; ++r)
#pragma unroll
                for (int c = 0; c < 4; ++c) {
                    xv[r][c] = *(const f32x4*)(xp + (size_t)r * DM + c * 256 + col0);
                    yr[r][c] = *(const u32x2*)(Y + (size_t)(row0 + r) * DM + c * 256 + col0);
                }
            const float* gate = MOD + ((size_t)l * 17 + mb) * 6144 + ug * 1024;
            const float* gam = p.norm_g + ((size_t)l * 4 + ugam) * DM;
            f32x4 gg[4];
#pragma unroll
            for (int c = 0; c < 4; ++c) gg[c] = *(const f32x4*)(gate + c * 256 + col0) * *(const f32x4*)(gam + c * 256 + col0);
            float ss[4];
#pragma unroll
            for (int r = 0; r < 4; ++r) {
                float s = 0.f;
#pragma unroll
                for (int c = 0; c < 4; ++c) s += dot4(bf4_to_f32(yr[r][c]));
                ss[r] = s;
            }
#pragma unroll
            for (int o = 1; o < 64; o <<= 1) {
#pragma unroll
                for (int r = 0; r < 4; ++r) ss[r] += __shfl_xor(ss[r], o);
            }
#pragma unroll
            for (int r = 0; r < 4; ++r) {
                const float rinv = rsqrtf(ss[r] * (1.f / DM) + EPS);
#pragma unroll
                for (int c = 0; c < 4; ++c) xv[r][c] = xv[r][c] + gg[c] * (bf4_to_f32(yr[r][c]) * rinv);
            }
        }
#pragma unroll
        for (int r = 0; r < 4; ++r)
#pragma unroll
            for (int c = 0; c < 4; ++c) *(f32x4*)(xp + (size_t)r * DM + c * 256 + col0) = xv[r][c];
        if (makeH) {
            float ss[4];
#pragma unroll
            for (int r = 0; r < 4; ++r) {
                float s = 0.f;
#pragma unroll
                for (int c = 0; c < 4; ++c) s += dot4(xv[r][c]);
                ss[r] = s;
            }
#pragma unroll
            for (int o = 1; o < 64; o <<= 1) {
#pragma unroll
                for (int r = 0; r < 4; ++r) ss[r] += __shfl_xor(ss[r], o);
            }
            const float* mrow = MOD + ((size_t)lh * 17 + mb) * 6144;
            const float* gam = p.norm_g + ((size_t)lh * 4 + hg) * DM;
#pragma unroll
            for (int c = 0; c < 4; ++c) {
                const int col = c * 256 + col0;
                const f32x4 sh = *(const f32x4*)(mrow + hsh * 1024 + col);
                const f32x4 sc = *(const f32x4*)(mrow + hsc * 1024 + col);
                const f32x4 gs = *(const f32x4*)(gam + col) * (sc + 1.f);
#pragma unroll
                for (int r = 0; r < 4; ++r) {
                    const float rinv = rsqrtf(ss[r] * (1.f / DM) + EPS);
                    const f32x4 hv = (xv[r][c] * rinv) * gs + sh;
                    u32x2 o; o[0] = pk2(hv[0], hv[1]); o[1] = pk2(hv[2], hv[3]);
                    *(u32x2*)(H + tiled_off(row0 + r, col, DM)) = o;
                }
            }
        }
    }
}

enum { EPI_EIN = 0, EPI_UQ = 1, EPI_UKV = 2, EPI_OIN = 3, EPI_Y = 4, EPI_FFN1 = 5 };

__device__ __forceinline__ void rope64(float (&v)[64], const float* R16, int t) {
    if (t < CTX) return;
    const int pp = t - CTX, pr = pp >> 6, pc = pp & 63;
    const float2* tr = (const float2*)R16 + pr * 16;
    const float2* tc = (const float2*)R16 + pc * 16;
#pragma unroll
    for (int i = 0; i < 16; ++i) {
        const float2 cs = tr[i];
        const float a = v[i], bb = v[i + 16];
        v[i] = a * cs.x - bb * cs.y; v[i + 16] = bb * cs.x + a * cs.y;
    }
#pragma unroll
    for (int i = 0; i < 16; ++i) {
        const float2 cs = tc[i];
        const float a = v[32 + i], bb = v[48 + i];
        v[32 + i] = a * cs.x - bb * cs.y; v[48 + i] = bb * cs.x + a * cs.y;
    }
}
template <int O>
__device__ __forceinline__ void rope32(float (&v)[64], const float* R8, int t) {
    if (t < CTX) return;
    const int pp = t - CTX, pr = pp >> 6, pc = pp & 63;
    const float2* tr = (const float2*)R8 + pr * 8;
    const float2* tc = (const float2*)R8 + pc * 8;
#pragma unroll
    for (int i = 0; i < 8; ++i) {
        const float2 cs = tr[i];
        const float a = v[O + i], bb = v[O + i + 8];
        v[O + i] = a * cs.x - bb * cs.y; v[O + i + 8] = bb * cs.x + a * cs.y;
    }
#pragma unroll
    for (int i = 0; i < 8; ++i) {
        const float2 cs = tc[i];
        const float a = v[O + 16 + i], bb = v[O + 24 + i];
        v[O + 16 + i] = a * cs.x - bb * cs.y; v[O + 24 + i] = bb * cs.x + a * cs.y;
    }
}
template <int N>
__device__ __forceinline__ void store_row(u16* dst, const float (&v)[64]) {
#pragma unroll
    for (int c = 0; c < N; c += 8) {
        uint4 o; o.x = pk2(v[c], v[c + 1]); o.y = pk2(v[c + 2], v[c + 3]); o.z = pk2(v[c + 4], v[c + 5]); o.w = pk2(v[c + 6], v[c + 7]);
        *(uint4*)(dst + c) = o;
    }
}
__device__ __forceinline__ void store_row_tiled64(u16* base, int row, int k0, int K, const float (&v)[64]) {
#pragma unroll
    for (int c = 0; c < 64; c += 8) {
        uint4 o; o.x = pk2(v[c], v[c + 1]); o.y = pk2(v[c + 2], v[c + 3]); o.z = pk2(v[c + 4], v[c + 5]); o.w = pk2(v[c + 6], v[c + 7]);
        *(uint4*)(base + tiled_off(row, k0 + c, K)) = o;
    }
}
__device__ __forceinline__ void store_k64(u16* head, int t, int d0, int NDS, const float (&v)[64]) {
#pragma unroll
    for (int c = 0; c < 64; c += 8) {
        uint4 o; o.x = pk2(v[c], v[c + 1]); o.y = pk2(v[c + 2], v[c + 3]); o.z = pk2(v[c + 4], v[c + 5]); o.w = pk2(v[c + 6], v[c + 7]);
        *(uint4*)(head + ktile_off(t, d0 + c, NDS)) = o;
    }
}
__device__ __forceinline__ void store_v64(u16* head, int dv0, int t, int NI, const float (&v)[64]) {
#pragma unroll
    for (int c = 0; c < 64; ++c) head[vtile_off(dv0 + c, t, NI)] = f2bf(v[c]);
}
__device__ __forceinline__ void store_T64(u16* dst, const float (&v)[64]) {
#pragma unroll
    for (int c = 0; c < 64; ++c) dst[(size_t)c * TOK] = f2bf(v[c]);
}
__device__ __forceinline__ float sumsq64(const float (&v)[64]) {
    float s = 0.f;
#pragma unroll
    for (int c = 0; c < 64; ++c) s += v[c] * v[c];
    return s;
}

template <int EPI>
__device__ __forceinline__ void epi_seg(const Params& p, int l, int row, int b, int t, int seg, float (&v)[64]) {
    unsigned char* ws = p.ws;
    const float* R16 = (const float*)(ws + OFF_R16);
    const float* R8 = (const float*)(ws + OFF_R8);
    if (EPI == EPI_EIN) {
        if (seg < 8) { rope64(v, R16, t); store_row<64>((u16*)(ws + P_QA) + (size_t)row * 512 + seg * 64, v); }
        else if (seg < 10) { rope64(v, R16, t); store_k64((u16*)(ws + P_KA) + ((size_t)(b * 2 + seg - 8) * TOK) * 64, t, 0, 2, v); }
        else if (seg < 12) { store_v64((u16*)(ws + P_VAT) + ((size_t)(b * 2 + seg - 10) * 64) * TOK, 0, t, 4, v); }
        else if (seg < 16) { ((float*)(ws + P_SS))[(size_t)row * 8 + seg - 12] = sumsq64(v); store_row_tiled64((u16*)(ws + P_CQ), row, (seg - 12) * 64, 256, v); }
        else if (seg < 18) { ((float*)(ws + P_SS))[(size_t)row * 8 + 4 + seg - 16] = sumsq64(v); store_row_tiled64((u16*)(ws + P_CKV), row, (seg - 16) * 64, 128, v); }
        else if (seg == 18) { rope32<0>(v, R8, t); store_row<32>((u16*)(ws + P_KPE) + (size_t)row * 32, v); }
    } else if (EPI == EPI_UQ) {
        const f32x4 s4 = *(const f32x4*)((const float*)(ws + P_SS) + (size_t)row * 8);
        const float rinv = rsqrtf((s4[0] + s4[1] + s4[2] + s4[3]) * (1.f / 256.f) + EPS);
#pragma unroll
        for (int c = 0; c < 64; ++c) v[c] *= rinv;
        if (((2 * seg) % 3) == 2) rope32<0>(v, R8, t);
        if (((2 * seg + 1) % 3) == 2) rope32<32>(v, R8, t);
        store_row<64>((u16*)(ws + P_QB) + (size_t)row * 768 + seg * 64, v);
    } else if (EPI == EPI_UKV) {
        const float* ssp = (const float*)(ws + P_SS) + (size_t)row * 8;
        const float rinv = rsqrtf((ssp[4] + ssp[5]) * (1.f / 128.f) + EPS);
#pragma unroll
        for (int c = 0; c < 64; ++c) v[c] *= rinv;
        const int h = seg >> 1;
        if ((seg & 1) == 0) {
            u16* kh = (u16*)(ws + P_KB) + ((size_t)(b * 8 + h) * TOK) * 96;
            store_k64(kh, t, 0, 3, v);
            const uint4* kp = (const uint4*)((const u16*)(ws + P_KPE) + (size_t)row * 32);
#pragma unroll
            for (int c = 0; c < 4; ++c) *(uint4*)(kh + ktile_off(t, 64 + c * 8, 3)) = kp[c];
        } else {
            store_v64((u16*)(ws + P_VBT) + ((size_t)(b * 8 + h) * 64) * TOK, 0, t, 4, v);
        }
    } else if (EPI == EPI_OIN) {
        const int o = l >> 1;
        if (seg < 10) {
            const float* g = p.od_qk_norm + (size_t)o * 128 + (seg < 8 ? 0 : 64);
            const float rinv = rsqrtf(sumsq64(v) * (1.f / 64.f) + EPS);
#pragma unroll
            for (int c = 0; c < 64; ++c) v[c] = v[c] * rinv * g[c];
            rope64(v, R16, t);
            if (seg < 8) store_row<64>((u16*)(ws + P_QC) + (size_t)row * 512 + seg * 64, v);
            else store_k64((u16*)(ws + P_KC) + ((size_t)(b * 2 + seg - 8) * TOK) * 64, t, 0, 2, v);
        } else if (seg < 12) { store_v64((u16*)(ws + P_VCT) + ((size_t)(b * 2 + seg - 10) * 64) * TOK, 0, t, 4, v); }
        else if (seg < 20) { rope64(v, R16, t); store_row<64>((u16*)(ws + P_QD) + (size_t)row * 512 + (seg - 12) * 64, v); }
        else if (seg < 28) { rope64(v, R16, t); store_k64((u16*)(ws + P_KD) + ((size_t)(b * 8 + seg - 20) * TOK) * 64, t, 0, 2, v); }
        else { const int s2 = seg - 28; store_v64((u16*)(ws + P_VDT) + ((size_t)(b * 4 + (s2 >> 1)) * 128) * TOK, (s2 & 1) * 64, t, 8, v); }
    } else if (EPI == EPI_Y) {
        store_row<64>((u16*)(ws + OFF_Y) + (size_t)row * DM + seg * 64, v);
    }
}

template <int EPI, int ROWS>
__device__ __forceinline__ void epi_process(const Params& p, int l, int m0, int n0, const float* Cs, int tid) {
    if (EPI == EPI_FFN1) {
        const int c8 = (tid & 7) * 8;
        u16* dst = (u16*)(p.ws + OFF_ACT) + (size_t)m0 * FFH + (n0 >> 7) * 64 + c8;
#pragma unroll
        for (int ps = 0; ps < ROWS / 32; ++ps) {
            const int rl = ps * 32 + (tid >> 3);
            const f32x4 g0 = *(const f32x4*)(Cs + rl * 132 + c8), g1 = *(const f32x4*)(Cs + rl * 132 + c8 + 4);
            const f32x4 u0 = *(const f32x4*)(Cs + rl * 132 + 64 + c8), u1 = *(const f32x4*)(Cs + rl * 132 + 64 + c8 + 4);
            float o[8];
#pragma unroll
            for (int c = 0; c < 4; ++c) { o[c] = g0[c] / (1.f + __expf(-g0[c])) * u0[c]; o[4 + c] = g1[c] / (1.f + __expf(-g1[c])) * u1[c]; }
            u32x4 w; w[0] = pk2(o[0], o[1]); w[1] = pk2(o[2], o[3]); w[2] = pk2(o[4], o[5]); w[3] = pk2(o[6], o[7]);
            *(u32x4*)(dst + (size_t)rl * FFH) = w;
        }
    } else if (EPI == EPI_Y) {
        const int c8 = (tid & 15) * 8;
        u16* dst = (u16*)(p.ws + OFF_Y) + (size_t)m0 * DM + n0 + c8;
#pragma unroll
        for (int ps = 0; ps < ROWS / 16; ++ps) {
            const int rl = ps * 16 + (tid >> 4);
            const f32x4 v0 = *(const f32x4*)(Cs + rl * 132 + c8), v1 = *(const f32x4*)(Cs + rl * 132 + c8 + 4);
            u32x4 w; w[0] = pk2(v0[0], v0[1]); w[1] = pk2(v0[2], v0[3]); w[2] = pk2(v1[0], v1[1]); w[3] = pk2(v1[2], v1[3]);
            *(u32x4*)(dst + (size_t)rl * DM) = w;
        }
    } else {
        if (tid < 2 * ROWS) {
            const int sl = tid / ROWS, rl = tid - sl * ROWS;
            const int row = m0 + rl;
            float v[64];
#pragma unroll
            for (int c = 0; c < 64; ++c) v[c] = Cs[rl * 129 + sl * 64 + c];
            const int b = row / TOK, t = row - b * TOK;
            epi_seg<EPI>(p, l, row, b, t, (n0 >> 6) + sl, v);
        }
    }
}

template <int EPI>
__device__ __forceinline__ void gemm_tile(const Params& p, int l, const u16* __restrict__ A, int lda, const u16* __restrict__ Bt, int K, int m0, int n0, unsigned char* smem) {
    const int tid = opaque_tid(), lane = tid & 63, wid = tid >> 6, wr = wid >> 1, wc = wid & 1, fr = lane & 15, fq = lane >> 4;
    f32x4 acc[4][4];
#pragma unroll
    for (int i = 0; i < 4; ++i)
#pragma unroll
        for (int j = 0; j < 4; ++j) acc[i][j] = (f32x4){0.f, 0.f, 0.f, 0.f};
    const unsigned voff = (unsigned)(lane * 16);
    const size_t ksub = (size_t)(K >> 5) * 1024;
    const unsigned char* Abase = (const unsigned char*)A + (size_t)(m0 >> 4) * ksub;
    const unsigned char* Bbase = (const unsigned char*)Bt + (size_t)(n0 >> 4) * ksub;
    (void)lda;
#define GLDS16(gp, lp) __builtin_amdgcn_global_load_lds((const unsigned*)(gp), (unsigned*)(lp), 16, 0, 0)
#define G_TILE(kt_, st_) do { const size_t ko_ = (size_t)(kt_) * 1024; unsigned char* d_ = smem + (st_) * 16384; \
        _Pragma("unroll") for (int s_ = 0; s_ < 8; ++s_) GLDS16(Abase + (size_t)s_ * ksub + ko_ + voff, d_ + s_ * 1024); \
        _Pragma("unroll") for (int s_ = 0; s_ < 8; ++s_) GLDS16(Bbase + (size_t)s_ * ksub + ko_ + voff, d_ + 8192 + s_ * 1024); } while (0)
    const int nk = K >> 5;
    G_TILE(wid, wid);
    const unsigned char* fa = smem + (wr * 4) * 1024 + fr * 64 + fq * 16;
    const unsigned char* fb = smem + 8192 + (wc * 4) * 1024 + fr * 64 + fq * 16;
    int st = 0, stn = 4;
    if (wid == 0) asm volatile("s_waitcnt vmcnt(0)" ::: "memory");
    __builtin_amdgcn_s_barrier();
    asm volatile("" ::: "memory");
    for (int kt = 0; kt < nk; ++kt) {
        if (((kt + 1) & 3) == wid && kt + 1 < nk) asm volatile("s_waitcnt vmcnt(0)" ::: "memory");
        __builtin_amdgcn_s_barrier();
        asm volatile("" ::: "memory");
        if ((kt & 3) == wid && kt + 4 < nk) G_TILE(kt + 4, stn);
        const int so = st * 16384;
        bf16x8 af[4], bv[4];
#pragma unroll
        for (int i = 0; i < 4; ++i) af[i] = *(const bf16x8*)(fa + so + i * 1024);
#pragma unroll
        for (int j = 0; j < 4; ++j) bv[j] = *(const bf16x8*)(fb + so + j * 1024);
        __builtin_amdgcn_s_setprio(1);
#pragma unroll
        for (int i = 0; i < 4; ++i)
#pragma unroll
            for (int j = 0; j < 4; ++j) acc[i][j] = __builtin_amdgcn_mfma_f32_16x16x32_bf16(af[i], bv[j], acc[i][j], 0, 0, 0);
        __builtin_amdgcn_s_setprio(0);
        st = (st == 4) ? 0 : st + 1;
        stn = (stn == 4) ? 0 : stn + 1;
    }
    __syncthreads();
    float* Cs = (float*)smem;
    constexpr int CS = (EPI == EPI_FFN1 || EPI == EPI_Y) ? 132 : 129;
#pragma unroll
    for (int i = 0; i < 4; ++i)
#pragma unroll
        for (int j = 0; j < 4; ++j)
#pragma unroll
            for (int r = 0; r < 4; ++r) Cs[(wr * 64 + i * 16 + fq * 4 + r) * CS + wc * 64 + j * 16 + fr] = acc[i][j][r];
    __syncthreads();
    epi_process<EPI, 128>(p, l, m0, n0, Cs, tid);
    __syncthreads();
}

template <int EPI>
__device__ __forceinline__ void gemm_tile3(const Params& p, int l, const u16* __restrict__ A, int lda, const u16* __restrict__ Bt, int K, int m0, int n0, unsigned char* smem) {
    const int tid = opaque_tid(), lane = tid & 63, wid = tid >> 6, wr = wid >> 1, wc = wid & 1, fr = lane & 15, fq = lane >> 4;
    f32x4 acc[6][4];
#pragma unroll
    for (int i = 0; i < 6; ++i)
#pragma unroll
        for (int j = 0; j < 4; ++j) acc[i][j] = (f32x4){0.f, 0.f, 0.f, 0.f};
    const unsigned voff = (unsigned)(lane * 16);
    const size_t ksub = (size_t)(K >> 5) * 1024;
    const unsigned char* Abase = (const unsigned char*)A + (size_t)(m0 >> 4) * ksub;
    const unsigned char* Bbase = (const unsigned char*)Bt + (size_t)(n0 >> 4) * ksub;
    (void)lda;
#define G3_TILE(kt_, st_) do { const size_t ko_ = (size_t)(kt_) * 1024; unsigned char* d_ = smem + (st_) * 20480; \
        _Pragma("unroll") for (int s_ = 0; s_ < 12; ++s_) GLDS16(Abase + (size_t)s_ * ksub + ko_ + voff, d_ + s_ * 1024); \
        _Pragma("unroll") for (int s_ = 0; s_ < 8; ++s_) GLDS16(Bbase + (size_t)s_ * ksub + ko_ + voff, d_ + 12288 + s_ * 1024); } while (0)
    const int nk = K >> 5;
    if (wid < 3) G3_TILE(wid, wid);
    const unsigned char* fa = smem + (wr * 6) * 1024 + fr * 64 + fq * 16;
    const unsigned char* fb = smem + 12288 + (wc * 4) * 1024 + fr * 64 + fq * 16;
    int st = 0, stn = 3;
    if (wid == 0) asm volatile("s_waitcnt vmcnt(0)" ::: "memory");
    asm volatile("s_waitcnt lgkmcnt(0)" ::: "memory");
    __builtin_amdgcn_s_barrier();
    asm volatile("" ::: "memory");
    for (int kt = 0; kt < nk; ++kt) {
        if (((kt + 1) & 3) == wid && kt + 1 < nk) asm volatile("s_waitcnt vmcnt(0)" ::: "memory");
        __builtin_amdgcn_s_barrier();
        asm volatile("" ::: "memory");
        if (((kt + 3) & 3) == wid && kt + 3 < nk) G3_TILE(kt + 3, stn);
        const int so = st * 20480;
        bf16x8 af[6], bv[4];
        {
            typedef __attribute__((address_space(3))) unsigned char lds_u8;
            const unsigned la = (unsigned)(uintptr_t)(lds_u8*)(fa + so);
            const unsigned lb = (unsigned)(uintptr_t)(lds_u8*)(fb + so);
#define DSR128(dst_, addr_, off_) asm volatile("ds_read_b128 %0, %1 offset:" #off_ : "=v"(dst_) : "v"(addr_))
            DSR128(bv[0], lb, 0); DSR128(bv[1], lb, 1024); DSR128(bv[2], lb, 2048); DSR128(bv[3], lb, 3072);
            DSR128(af[0], la, 0); DSR128(af[1], la, 1024); DSR128(af[2], la, 2048); DSR128(af[3], la, 3072); DSR128(af[4], la, 4096); DSR128(af[5], la, 5120);
        }
        __builtin_amdgcn_sched_barrier(0);
        asm volatile("s_waitcnt lgkmcnt(5)" : "+v"(bv[0]), "+v"(bv[1]), "+v"(bv[2]), "+v"(bv[3]), "+v"(af[0]));
        __builtin_amdgcn_sched_barrier(0);
#pragma unroll
        for (int j = 0; j < 4; ++j) acc[0][j] = __builtin_amdgcn_mfma_f32_16x16x32_bf16(bv[j], af[0], acc[0][j], 0, 0, 0);
        __builtin_amdgcn_sched_barrier(0);
        asm volatile("s_waitcnt lgkmcnt(4)" : "+v"(af[1]));
        __builtin_amdgcn_sched_barrier(0);
#pragma unroll
        for (int j = 0; j < 4; ++j) acc[1][j] = __builtin_amdgcn_mfma_f32_16x16x32_bf16(bv[j], af[1], acc[1][j], 0, 0, 0);
        __builtin_amdgcn_sched_barrier(0);
        asm volatile("s_waitcnt lgkmcnt(3)" : "+v"(af[2]));
        __builtin_amdgcn_sched_barrier(0);
#pragma unroll
        for (int j = 0; j < 4; ++j) acc[2][j] = __builtin_amdgcn_mfma_f32_16x16x32_bf16(bv[j], af[2], acc[2][j], 0, 0, 0);
        __builtin_amdgcn_sched_barrier(0);
        asm volatile("s_waitcnt lgkmcnt(2)" : "+v"(af[3]));
        __builtin_amdgcn_sched_barrier(0);
#pragma unroll
        for (int j = 0; j < 4; ++j) acc[3][j] = __builtin_amdgcn_mfma_f32_16x16x32_bf16(bv[j], af[3], acc[3][j], 0, 0, 0);
        __builtin_amdgcn_sched_barrier(0);
        asm volatile("s_waitcnt lgkmcnt(1)" : "+v"(af[4]));
        __builtin_amdgcn_sched_barrier(0);
#pragma unroll
        for (int j = 0; j < 4; ++j) acc[4][j] = __builtin_amdgcn_mfma_f32_16x16x32_bf16(bv[j], af[4], acc[4][j], 0, 0, 0);
        __builtin_amdgcn_sched_barrier(0);
        asm volatile("s_waitcnt lgkmcnt(0)" : "+v"(af[5]));
        __builtin_amdgcn_sched_barrier(0);
#pragma unroll
        for (int j = 0; j < 4; ++j) acc[5][j] = __builtin_amdgcn_mfma_f32_16x16x32_bf16(bv[j], af[5], acc[5][j], 0, 0, 0);
        st = (st + 1) & 3;
        stn = (stn + 1) & 3;
    }
    __syncthreads();
    static_assert(EPI == EPI_FFN1 || EPI == EPI_Y, "gemm_tile3 has the plain epilogues only");
    const int rowb = m0 + wr * 96 + fr;
    if (EPI == EPI_Y) {
        u16* dst = (u16*)(p.ws + OFF_Y) + (size_t)rowb * DM + n0 + wc * 64 + fq * 4;
#pragma unroll
        for (int i = 0; i < 6; ++i)
#pragma unroll
            for (int j = 0; j < 4; ++j) {
                u32x2 w; w[0] = pk2(acc[i][j][0], acc[i][j][1]); w[1] = pk2(acc[i][j][2], acc[i][j][3]);
                *(u32x2*)(dst + (size_t)(i * 16) * DM + j * 16) = w;
            }
    } else {
        u16* actb = (u16*)(p.ws + OFF_ACT);
        const int colb = (n0 >> 1) + wc * 32 + fq * 4;
#pragma unroll
        for (int i = 0; i < 6; ++i)
#pragma unroll
            for (int jp = 0; jp < 2; ++jp) {
                float o[4];
#pragma unroll
                for (int r = 0; r < 4; ++r) { const float g = acc[i][2 * jp][r], u = acc[i][2 * jp + 1][r]; o[r] = g / (1.f + __expf(-g)) * u; }
                u32x2 w; w[0] = pk2(o[0], o[1]); w[1] = pk2(o[2], o[3]);
                *(u32x2*)(actb + tiled_off(rowb + i * 16, colb + jp * 16, FFH)) = w;
            }
    }
}

__device__ __forceinline__ bool tile_order(int r, int total, int nN, int& mt, int& nt) {
    const int nloc = gridDim.x >> 3, xcd = blockIdx.x & 7, li = blockIdx.x >> 3;
    const int L = (r * 8 + xcd) * nloc + li;
    if (L >= total) return false;
    const int band = L / (8 * nN), rem = L - band * 8 * nN;
    nt = rem >> 3; mt = band * 8 + (rem & 7);
    return true;
}
template <int EPI>
__device__ __forceinline__ void gemm_phase(const Params& p, int l, const u16* A, int lda, const u16* Bt, int K, int nN, bool skip_ctx, unsigned char* smem) {
    const int nM = skip_ctx ? 256 : 288;
    const int total = nM * nN;
    for (int r = 0;; ++r) {
        int mt, nt;
        if (!tile_order(r, total, nN, mt, nt)) break;
        if (skip_ctx) mt = (mt >> 4) * 18 + 2 + (mt & 15);
        gemm_tile<EPI>(p, l, A, lda, Bt, K, mt * 128, nt * 128, smem);
    }
}

template <int EPI>
__device__ __forceinline__ void gemm_phase3(const Params& p, int l, const u16* A, int lda, const u16* Bt, int K, int nN, bool skip_ctx, unsigned char* smem) {
    const int nM = skip_ctx ? 176 : 192;
    const int total = nM * nN;
    for (int r = 0;; ++r) {
        int mt, nt;
        if (!tile_order(r, total, nN, mt, nt)) break;
        if (skip_ctx) { const int bb = mt / 11; mt = bb * 12 + 1 + (mt - bb * 11); }
        gemm_tile3<EPI>(p, l, A, lda, Bt, K, mt * 192, nt * 128, smem);
    }
}

typedef __attribute__((address_space(3))) unsigned char lds_byte_t;
template <int OFF> __device__ __forceinline__ void dsr128(bf16x8& d, unsigned addr) { asm volatile("ds_read_b128 %0, %1 offset:%2" : "=v"(d) : "v"(addr), "n"(OFF)); }
template <int N> __device__ __forceinline__ void wait_lgkm_frag(bf16x8& r) { asm volatile("s_waitcnt lgkmcnt(%1)" : "+v"(r) : "n"(N)); }
template <int NI, int NQB, int KC, int I>
__device__ __forceinline__ void pv_frags(bf16x8 (&vb)[3], unsigned va, const bf16x8 (&pf)[NQB], f32x4 (&o)[NQB][NI]) {
    if constexpr (I + 2 < NI) dsr128<((I + 2) * 2 + KC) * 1024>(vb[(I + 2) % 3], va);
    wait_lgkm_frag<((NI - 1 - I) < 2 ? (NI - 1 - I) : 2)>(vb[I % 3]);
    __builtin_amdgcn_sched_barrier(0);
#pragma unroll
    for (int qb = 0; qb < NQB; ++qb) o[qb][I] = __builtin_amdgcn_mfma_f32_16x16x32_bf16(vb[I % 3], pf[qb], o[qb][I], 0, 0, 0);
    __builtin_amdgcn_sched_barrier(0);
    if constexpr (I + 1 < NI) pv_frags<NI, NQB, KC, I + 1>(vb, va, pf, o);
}
template <int NI, int NQB, int KC>
__device__ __forceinline__ void pv_chunk(unsigned va, const bf16x8 (&pf)[NQB], f32x4 (&o)[NQB][NI]) {
    bf16x8 vb[3];
    __builtin_amdgcn_sched_barrier(0);
    dsr128<(0 * 2 + KC) * 1024>(vb[0], va);
    dsr128<(1 * 2 + KC) * 1024>(vb[1], va);
    pv_frags<NI, NQB, KC, 0>(vb, va, pf, o);
}
template <int NDS, int NQB, int F>
__device__ __forceinline__ void s_frags(bf16x8 (&kb)[3], unsigned ka, const bf16x8 (&qf)[NQB][NDS], f32x4 (&s)[4][NQB]) {
    constexpr int NF = 4 * NDS;
    if constexpr (F + 2 < NF) dsr128<(((F + 2) % 4) * NDS + (F + 2) / 4) * 1024>(kb[(F + 2) % 3], ka);
    wait_lgkm_frag<((NF - 1 - F) < 2 ? (NF - 1 - F) : 2)>(kb[F % 3]);
    __builtin_amdgcn_sched_barrier(0);
#pragma unroll
    for (int qb = 0; qb < NQB; ++qb) s[F % 4][qb] = __builtin_amdgcn_mfma_f32_16x16x32_bf16(kb[F % 3], qf[qb][F / 4], s[F % 4][qb], 0, 0, 0);
    __builtin_amdgcn_sched_barrier(0);
    if constexpr (F + 1 < NF) s_frags<NDS, NQB, F + 1>(kb, ka, qf, s);
}
template <int NDS, int NQB, int KC, int F>
__device__ __forceinline__ void sh_frags(bf16x8 (&kb)[3], unsigned ka, const bf16x8 (&qf)[NQB][NDS], f32x4 (&s)[2][NQB]) {
    constexpr int NF = 2 * NDS;
    if constexpr (F + 2 < NF) dsr128<((2 * KC + (F + 2) % 2) * NDS + (F + 2) / 2) * 1024>(kb[(F + 2) % 3], ka);
    wait_lgkm_frag<((NF - 1 - F) < 2 ? (NF - 1 - F) : 2)>(kb[F % 3]);
    __builtin_amdgcn_sched_barrier(0);
#pragma unroll
    for (int qb = 0; qb < NQB; ++qb) s[F % 2][qb] = __builtin_amdgcn_mfma_f32_16x16x32_bf16(kb[F % 3], qf[qb][F / 2], s[F % 2][qb], 0, 0, 0);
    __builtin_amdgcn_sched_barrier(0);
    if constexpr (F + 1 < NF) sh_frags<NDS, NQB, KC, F + 1>(kb, ka, qf, s);
}
template <int NDS, int NQB, int KC>
__device__ __forceinline__ void sh_chunk(unsigned ka, const bf16x8 (&qf)[NQB][NDS], f32x4 (&s)[2][NQB]) {
    bf16x8 kb[3];
    __builtin_amdgcn_sched_barrier(0);
    dsr128<((2 * KC + 0) * NDS + 0) * 1024>(kb[0], ka);
    dsr128<((2 * KC + 1) * NDS + 0) * 1024>(kb[1], ka);
    sh_frags<NDS, NQB, KC, 0>(kb, ka, qf, s);
}
template <int N> __device__ __forceinline__ void wait_vm() { asm volatile("s_waitcnt vmcnt(%0)" :: "n"(N) : "memory"); }

template <int DQK, int DV, int NQB, int MODE, bool HALF = false>
__device__ __forceinline__ void attn_pass(const u16* __restrict__ Qw, int ldq, const u16* __restrict__ Kb, const u16* __restrict__ Vtb,
                                          int ra0, int ra1, int rb0, int rb1, float scale_log2, float sink_log2, int qpos0,
                                          unsigned char* smem, f32x4 (&o)[NQB][DV / 16]) {
    constexpr int NDS = DQK / 32, NI = DV / 16;
    constexpr int KBYTES = 4 * NDS * 1024, VBYTES = NI * 2 * 1024, STG = KBYTES + VBYTES;
    constexpr int NST = (LDS_BYTES / STG) > 4 ? 4 : (LDS_BYTES / STG);
    constexpr int KPW = NDS, VPW = NI / 2, IPT = KPW + VPW;
    static_assert(NST >= 3, "ring too shallow");
    const int tid = opaque_tid(), lane = tid & 63, wid = tid >> 6, fr = lane & 15, fq = lane >> 4;
    bf16x8 qf[NQB][DQK / 32];
#pragma unroll
    for (int qb = 0; qb < NQB; ++qb)
#pragma unroll
        for (int ks = 0; ks < DQK / 32; ++ks) qf[qb][ks] = *(const bf16x8*)(Qw + (size_t)(qb * 16 + fr) * ldq + ks * 32 + fq * 8);
    float m[NQB];
    f32x4 lacc[NQB];
    const bf16x8 ones = {(short)0x3F80, (short)0x3F80, (short)0x3F80, (short)0x3F80, (short)0x3F80, (short)0x3F80, (short)0x3F80, (short)0x3F80};
#pragma unroll
    for (int qb = 0; qb < NQB; ++qb) {
        m[qb] = (MODE == 1) ? sink_log2 : -INFINITY;
        { const float l0 = (MODE == 1) ? 1.f : 0.f; lacc[qb] = (f32x4){l0, l0, l0, l0}; }
#pragma unroll
        for (int i = 0; i < DV / 16; ++i) o[qb][i] = (f32x4){0.f, 0.f, 0.f, 0.f};
    }
    const int nA = ra1 - ra0, ntiles = nA + (rb1 - rb0);
    const unsigned voff = (unsigned)(lane * 16);
    const unsigned char* Kbase = (const unsigned char*)Kb;
    const unsigned char* Vbase = (const unsigned char*)Vtb;
#define A_ISSUE(kt_, st_) do { unsigned char* sb_ = smem + (st_) * STG; \
        const unsigned char* kp_ = Kbase + (size_t)(kt_) * KBYTES + voff; const unsigned char* vp_ = Vbase + (size_t)(kt_) * VBYTES + voff; \
        _Pragma("unroll") for (int kb_ = 0; kb_ < 4 * NDS; ++kb_) GLDS16(kp_ + kb_ * 1024, sb_ + kb_ * 1024); \
        _Pragma("unroll") for (int vb_ = 0; vb_ < 2 * NI; ++vb_) GLDS16(vp_ + vb_ * 1024, sb_ + KBYTES + vb_ * 1024); } while (0)
#define A_TILE(it_) (((it_) < nA) ? (ra0 + (it_)) : (rb0 + (it_) - nA))
    if (wid < NST - 1 && wid < ntiles) A_ISSUE(A_TILE(wid), wid);
    if (wid == 0) wait_vm<0>();
    __builtin_amdgcn_s_barrier();
    asm volatile("" ::: "memory");
    int st = 0, stn = NST - 1;
    for (int it = 0; it < ntiles; ++it) {
        const int kt = A_TILE(it);
        if (((it + 1) & 3) == wid && it + 1 < ntiles) wait_vm<0>();
        __builtin_amdgcn_s_barrier();
        asm volatile("" ::: "memory");
        if (((it + NST - 1) & 3) == wid && it + NST - 1 < ntiles) { A_ISSUE(A_TILE(it + NST - 1), stn); }
        const unsigned char* Ks = smem + st * STG + fr * 64 + fq * 16;
        const unsigned char* Vs = Ks + KBYTES;
        if constexpr (HALF) {
            const unsigned ka = (unsigned)(uintptr_t)(lds_byte_t*)Ks;
            const unsigned va = (unsigned)(uintptr_t)(lds_byte_t*)Vs;
#pragma unroll
            for (int kc = 0; kc < 2; ++kc) {
                f32x4 s[2][NQB];
#pragma unroll
                for (int kl = 0; kl < 2; ++kl)
#pragma unroll
                    for (int qb = 0; qb < NQB; ++qb) s[kl][qb] = (f32x4){0.f, 0.f, 0.f, 0.f};
                if (kc == 0) sh_chunk<NDS, NQB, 0>(ka, qf, s); else sh_chunk<NDS, NQB, 1>(ka, qf, s);
                float mxl[NQB];
                bool need = false;
#pragma unroll
                for (int qb = 0; qb < NQB; ++qb) {
                    float mx = -INFINITY;
#pragma unroll
                    for (int kl = 0; kl < 2; ++kl)
#pragma unroll
                        for (int j = 0; j < 4; ++j) {
                            float v = s[kl][qb][j];
                            if (MODE == 1) {
                                if (kt >= 4) {
                                    const int d = (qpos0 + qb * 16 + fr) - ((kt - 4) * 64 + 32 * kc + fq * 8 + kl * 4 + j);
                                    if (d > 128 || d < -128) v = -1e30f;
                                }
                                s[kl][qb][j] = v;
                            }
                            mx = fmaxf(mx, v);
                        }
                    mxl[qb] = mx;
                    need = need || (mx * scale_log2 > m[qb] + 8.f);
                }
                if (__any(need)) {
#pragma unroll
                    for (int qb = 0; qb < NQB; ++qb) {
                        float mx = mxl[qb];
                        mx = fmaxf(mx, __shfl_xor(mx, 16));
                        mx = fmaxf(mx, __shfl_xor(mx, 32));
                        const float mnew = fmaxf(m[qb], mx * scale_log2);
                        const float alpha = __builtin_amdgcn_exp2f(m[qb] - mnew);
                        m[qb] = mnew;
                        lacc[qb] = lacc[qb] * alpha;
#pragma unroll
                        for (int i = 0; i < DV / 16; ++i) o[qb][i] = o[qb][i] * alpha;
                    }
                }
                bf16x8 pf[NQB];
#pragma unroll
                for (int qb = 0; qb < NQB; ++qb) {
                    const float mq = m[qb];
                    float e[2][4];
#pragma unroll
                    for (int kl = 0; kl < 2; ++kl)
#pragma unroll
                        for (int j = 0; j < 4; ++j) e[kl][j] = __builtin_amdgcn_exp2f(__builtin_fmaf(s[kl][qb][j], scale_log2, -mq));
                    u32x4 cu;
                    cu[0] = pk2(e[0][0], e[0][1]); cu[1] = pk2(e[0][2], e[0][3]); cu[2] = pk2(e[1][0], e[1][1]); cu[3] = pk2(e[1][2], e[1][3]);
                    pf[qb] = __builtin_bit_cast(bf16x8, cu);
                    lacc[qb] = __builtin_amdgcn_mfma_f32_16x16x32_bf16(ones, pf[qb], lacc[qb], 0, 0, 0);
                }
                if (kc == 0) pv_chunk<DV / 16, NQB, 0>(va, pf, o); else pv_chunk<DV / 16, NQB, 1>(va, pf, o);
            }
        } else {
        f32x4 s[4][NQB];
#pragma unroll
        for (int kk = 0; kk < 4; ++kk)
#pragma unroll
            for (int qb = 0; qb < NQB; ++qb) s[kk][qb] = (f32x4){0.f, 0.f, 0.f, 0.f};
        {
            const unsigned ka = (unsigned)(uintptr_t)(lds_byte_t*)Ks;
            bf16x8 kb[3];
            __builtin_amdgcn_sched_barrier(0);
            dsr128<(0 * NDS + 0) * 1024>(kb[0], ka);
            dsr128<(1 * NDS + 0) * 1024>(kb[1], ka);
            s_frags<NDS, NQB, 0>(kb, ka, qf, s);
        }
        float mxl[NQB];
        bool need = false;
#pragma unroll
        for (int qb = 0; qb < NQB; ++qb) {
            float mx = -INFINITY;
#pragma unroll
            for (int kk = 0; kk < 4; ++kk)
#pragma unroll
                for (int j = 0; j < 4; ++j) {
                    float v = s[kk][qb][j];
                    if (MODE == 1) {
                        if (kt >= 4) {
                            const int d = (qpos0 + qb * 16 + fr) - ((kt - 4) * 64 + 32 * (kk >> 1) + fq * 8 + (kk & 1) * 4 + j);
                            if (d > 128 || d < -128) v = -1e30f;
                        }
                        s[kk][qb][j] = v;
                    }
                    mx = fmaxf(mx, v);
                }
            mxl[qb] = mx;
            need = need || (mx * scale_log2 > m[qb] + 8.f);
        }
        if (__any(need)) {
#pragma unroll
            for (int qb = 0; qb < NQB; ++qb) {
                float mx = mxl[qb];
                mx = fmaxf(mx, __shfl_xor(mx, 16));
                mx = fmaxf(mx, __shfl_xor(mx, 32));
                const float mnew = fmaxf(m[qb], mx * scale_log2);
                const float alpha = __builtin_amdgcn_exp2f(m[qb] - mnew);
                m[qb] = mnew;
                lacc[qb] = lacc[qb] * alpha;
#pragma unroll
                for (int i = 0; i < DV / 16; ++i) o[qb][i] = o[qb][i] * alpha;
            }
        }
#pragma unroll
        for (int qb = 0; qb < NQB; ++qb) {
            const float mq = m[qb];
#pragma unroll
            for (int kk = 0; kk < 4; ++kk)
#pragma unroll
                for (int j = 0; j < 4; ++j) s[kk][qb][j] = __builtin_amdgcn_exp2f(__builtin_fmaf(s[kk][qb][j], scale_log2, -mq));
        }
#pragma unroll
        for (int kc = 0; kc < 2; ++kc) {
            bf16x8 pf[NQB];
#pragma unroll
            for (int qb = 0; qb < NQB; ++qb) {
                u32x4 cu;
                cu[0] = pk2(s[2 * kc][qb][0], s[2 * kc][qb][1]); cu[1] = pk2(s[2 * kc][qb][2], s[2 * kc][qb][3]);
                cu[2] = pk2(s[2 * kc + 1][qb][0], s[2 * kc + 1][qb][1]); cu[3] = pk2(s[2 * kc + 1][qb][2], s[2 * kc + 1][qb][3]);
                pf[qb] = __builtin_bit_cast(bf16x8, cu);
                lacc[qb] = __builtin_amdgcn_mfma_f32_16x16x32_bf16(ones, pf[qb], lacc[qb], 0, 0, 0);
            }
            const unsigned va = (unsigned)(uintptr_t)(lds_byte_t*)Vs;
            if (kc == 0) pv_chunk<DV / 16, NQB, 0>(va, pf, o); else pv_chunk<DV / 16, NQB, 1>(va, pf, o);
        }
        }
        st = (st + 1 == NST) ? 0 : st + 1;
        stn = (stn + 1 == NST) ? 0 : stn + 1;
    }
#pragma unroll
    for (int qb = 0; qb < NQB; ++qb) {
        const float inv = 1.f / lacc[qb][0];
#pragma unroll
        for (int i = 0; i < DV / 16; ++i) o[qb][i] = o[qb][i] * inv;
    }
    __syncthreads();
}

template <int NQB, int NI>
__device__ __forceinline__ void store_o(u16* O, int row0, int col0, const f32x4 (&o)[NQB][NI]) {
    const int lane = opaque_tid() & 63, fr = lane & 15, fq = lane >> 4;
#pragma unroll
    for (int qb = 0; qb < NQB; ++qb)
#pragma unroll
        for (int i = 0; i < NI; ++i) {
            uint2 w; w.x = pk2(o[qb][i][0], o[qb][i][1]); w.y = pk2(o[qb][i][2], o[qb][i][3]);
            *(uint2*)(O + tiled_off(row0 + qb * 16 + fr, col0 + i * 16 + fq * 4, DM)) = w;
        }
}

__device__ __forceinline__ void attn_even_phase(const Params& p, int l, unsigned char* smem) {
    const int wid = opaque_tid() >> 6;
    const int e = l >> 1;
    const bool last = (l == 3);
    const int nq = last ? 16 : 18;
    const int nB = NBATCH * 8 * nq;
    unsigned char* ws = p.ws;
    u16* O = (u16*)(ws + OFF_HO);
    (void)nq; (void)nB;
    const int total = last ? 3072 : 3072 + 128 + 256;
    for (int it = blockIdx.x; it < total; it += gridDim.x) {
        bool isB; int qt, h, b;
        if (it < 3072) {
            isB = it < 1024; const int r = isB ? it : it - 1024;
            if (isB) { qt = 1 + (r & 7); h = (r >> 3) & 7; b = r >> 6; } else { qt = 2 + (r & 15); h = (r >> 4) & 7; b = r >> 7; }
        } else {
            const int r2 = it - 3072; isB = r2 < 128; const int r = isB ? r2 : r2 - 128;
            if (isB) { qt = 0; h = r & 7; b = r >> 3; } else { qt = r & 1; h = (r >> 1) & 7; b = r >> 4; }
        }
        if (isB) {
            const int row0 = b * TOK + qt * 256 + wid * 64;
            f32x4 o[4][4];
            const u16* Q = (const u16*)(ws + P_QB) + (size_t)row0 * 768 + h * 96;
            const u16* Kb = (const u16*)(ws + P_KB) + ((size_t)(b * 8 + h) * TOK) * 96;
            const u16* Vt = (const u16*)(ws + P_VBT) + ((size_t)(b * 8 + h) * 64) * TOK;
            attn_pass<96, 64, 4, 0, true>(Q, 768, Kb, Vt, 0, (qt < 1) ? 4 : 36, 0, 0, 0.10206207261596577f * LOG2E, 0.f, 0, smem, o);
            store_o<4, 4>(O, row0, 512 + h * 64, o);
        } else {
            const int row0 = b * TOK + qt * 128 + wid * 32;
            f32x4 o[2][4];
            const int kvh = h >> 2;
            const u16* Q = (const u16*)(ws + P_QA) + (size_t)row0 * 512 + h * 64;
            const u16* Kb = (const u16*)(ws + P_KA) + ((size_t)(b * 2 + kvh) * TOK) * 64;
            const u16* Vt = (const u16*)(ws + P_VAT) + ((size_t)(b * 2 + kvh) * 64) * TOK;
            const float sink = p.ev_sink[e * 8 + h] * LOG2E;
            int rb0 = 0, rb1 = 0, qpos0 = 0;
            if (qt >= 2) {
                const int n = qt - 2;
                rb0 = (n == 0) ? 4 : 2 * n + 2;
                rb1 = (2 * n + 8 > 36) ? 36 : 2 * n + 8;
                qpos0 = n * 128 + wid * 32;
            }
            attn_pass<64, 64, 2, 1>(Q, 512, Kb, Vt, 0, 4, rb0, rb1, 0.125f * LOG2E, sink, qpos0, smem, o);
            store_o<2, 4>(O, row0, h * 64, o);
        }
    }
}

__device__ __forceinline__ void attn_odd_phase(const Params& p, int l, unsigned char* smem) {
    const int tid0 = opaque_tid(); const int lane = tid0 & 63, wid = tid0 >> 6, fr = lane & 15, fq = lane >> 4;
    const int oi = l >> 1;
    const bool last = (l == 3);
    const int nqd = last ? 32 : 36, nqc = last ? 16 : 18;
    const int nD = NBATCH * 4 * nqd, nC = NBATCH * 8 * nqc;
    unsigned char* ws = p.ws;
    u16* O = (u16*)(ws + OFF_HO);
    const float lam = ((const float*)(ws + OFF_LAM))[oi];
    const float post = 1.f - lam_init_of(l);
    (void)nD; (void)nC;
    const int total = last ? 2048 : 2048 + 128 + 128;
    for (int it = blockIdx.x; it < total; it += gridDim.x) {
        bool isD; int qx, h, b;
        if (it < 2048) {
            isD = it < 1024; const int r = isD ? it : it - 1024;
            if (isD) { qx = 2 + (r & 15); h = (r >> 4) & 3; b = r >> 6; } else { qx = 1 + (r & 7); h = (r >> 3) & 7; b = r >> 6; }
        } else {
            const int r2 = it - 2048; isD = r2 < 128; const int r = isD ? r2 : r2 - 128;
            if (isD) { qx = r & 1; h = (r >> 1) & 3; b = r >> 3; } else { qx = 0; h = r & 7; b = r >> 3; }
        }
        if (isD) {
            const int row0 = b * TOK + qx * 128 + wid * 32;
            const int hi = (qx < 2) ? 4 : 36;
            const u16* Vt = (const u16*)(ws + P_VDT) + ((size_t)(b * 4 + h) * 128) * TOK;
            f32x4 o0[2][8], o1[2][8];
            {
                const u16* Q = (const u16*)(ws + P_QD) + (size_t)row0 * 512 + (h * 2) * 64;
                const u16* Kb = (const u16*)(ws + P_KD) + ((size_t)(b * 8 + h * 2) * TOK) * 64;
                attn_pass<64, 128, 2, 0>(Q, 512, Kb, Vt, 0, hi, 0, 0, 0.125f * LOG2E, 0.f, 0, smem, o0);
            }
            {
                const u16* Q = (const u16*)(ws + P_QD) + (size_t)row0 * 512 + (h * 2 + 1) * 64;
                const u16* Kb = (const u16*)(ws + P_KD) + ((size_t)(b * 8 + h * 2 + 1) * TOK) * 64;
                attn_pass<64, 128, 2, 0>(Q, 512, Kb, Vt, 0, hi, 0, 0, 0.125f * LOG2E, 0.f, 0, smem, o1);
            }
            const float* sg = p.od_subln + oi * 128;
#pragma unroll
            for (int qb = 0; qb < 2; ++qb) {
                float ss = 0.f;
#pragma unroll
                for (int i = 0; i < 8; ++i) {
                    o0[qb][i] = o0[qb][i] - o1[qb][i] * lam;
                    ss += o0[qb][i][0] * o0[qb][i][0] + o0[qb][i][1] * o0[qb][i][1] + o0[qb][i][2] * o0[qb][i][2] + o0[qb][i][3] * o0[qb][i][3];
                }
                ss += __shfl_xor(ss, 16);
                ss += __shfl_xor(ss, 32);
                const float rinv = rsqrtf(ss * (1.f / 128.f) + EPS) * post;
#pragma unroll
                for (int i = 0; i < 8; ++i) {
                    const f32x4 g = *(const f32x4*)(sg + i * 16 + fq * 4);
                    o0[qb][i] = o0[qb][i] * rinv * g;
                }
            }
            store_o<2, 8>(O, row0, 512 + h * 128, o0);
        } else {
            const int qt = qx;
            const int row0 = b * TOK + qt * 256 + wid * 64;
            const int kvh = h >> 2;
            const u16* Q = (const u16*)(ws + P_QC) + (size_t)row0 * 512 + h * 64;
            const u16* Kb = (const u16*)(ws + P_KC) + ((size_t)(b * 2 + kvh) * TOK) * 64;
            const u16* Vt = (const u16*)(ws + P_VCT) + ((size_t)(b * 2 + kvh) * 64) * TOK;
            f32x4 o[4][4];
            attn_pass<64, 64, 4, 0, true>(Q, 512, Kb, Vt, 0, (qt < 1) ? 4 : 36, 0, 0, 0.125f * LOG2E, 0.f, 0, smem, o);
            store_o<4, 4>(O, row0, h * 64, o);
        }
    }
}

#define XB_TMO      128
#define XB_XCNT(j)  (256  + 64 * (j))
#define XB_XSUB(j)  (1280 + 64 * (j))
#define XB_XGEN(j)  (2304 + 64 * (j))
#define XB_TOP      3328
#define XB_TOPGEN   3392
#define XCD_BAR_WORDS 3456
#define XB_SPIN_CAP (1u << 20)
#define LAS __attribute__((address_space(3)))
__device__ __forceinline__ unsigned xb_ld(unsigned* p)              { return __hip_atomic_load(p, __ATOMIC_RELAXED, __HIP_MEMORY_SCOPE_AGENT); }
__device__ __forceinline__ unsigned xb_add(unsigned* p, unsigned v) { return __hip_atomic_fetch_add(p, v, __ATOMIC_RELAXED, __HIP_MEMORY_SCOPE_AGENT); }
__device__ __forceinline__ unsigned xb_xcc_id() { return (unsigned)__builtin_amdgcn_s_getreg((3 << 11) | 20) & 0xFu; }
#define XB_SPIN(cond, bar) do { unsigned _sp = 0; while (cond) { __builtin_amdgcn_s_sleep(1); \
    if ((++_sp & 255u) == 0u) { if (xb_ld(&(bar)[XB_TMO])) break; if (_sp > XB_SPIN_CAP) { atomicAdd(&(bar)[XB_TMO], 1u); break; } } } } while (0)
struct XcdBarrier { unsigned* bar; unsigned x; unsigned nloc, nx; };
__device__ __forceinline__ XcdBarrier xcd_barrier_post(unsigned* bar) {
    XcdBarrier b; b.bar = bar; b.x = xb_xcc_id(); b.nloc = 0u; b.nx = 0u;
    if (threadIdx.x == 0) (void)xb_add(&bar[XB_XCNT(b.x)], 1u);
    return b;
}
__device__ __forceinline__ void xcd_barrier_complete(unsigned* bar, unsigned x, unsigned& nloc, unsigned& nx) {
    const unsigned G = gridDim.x * gridDim.y * gridDim.z;
    unsigned sum, cnt, mine, sp = 0u;
    for (;;) {
        sum = 0u; cnt = 0u; mine = 0u;
#pragma unroll
        for (unsigned j = 0; j < 16; ++j) { const unsigned c = xb_ld(&bar[XB_XCNT(j)]); sum += c; cnt += (c > 0u) ? 1u : 0u; mine = (j == x) ? c : mine; }
        if (sum == G) break;
        __builtin_amdgcn_s_sleep(1);
        if ((++sp & 255u) == 0u) { if (xb_ld(&bar[XB_TMO])) break; if (sp > XB_SPIN_CAP) { atomicAdd(&bar[XB_TMO], 1u); break; } }
    }
    nloc = mine > 0u ? mine : 1u; nx = cnt > 0u ? cnt : 1u;
}
__device__ __forceinline__ void xcd_barrier(XcdBarrier& b) {
    asm volatile("s_waitcnt vmcnt(0)" ::: "memory");
    __syncthreads();
    if (threadIdx.x == 0) {
        unsigned* bar = b.bar;
        __builtin_amdgcn_s_waitcnt(0);
        unsigned nloc = b.nloc, nx = b.nx;
        if (nloc == 0u) { xcd_barrier_complete(bar, b.x, nloc, nx); b.nloc = nloc; b.nx = nx; }
        const unsigned old = xb_add(&bar[XB_XSUB(b.x)], 1u);
        const unsigned gen = old / nloc;
        if (old + 1u == (gen + 1u) * nloc) {
            __builtin_amdgcn_fence(__ATOMIC_RELEASE, "agent");
            asm volatile("s_waitcnt vmcnt(0)" ::: "memory");
            const unsigned og = xb_add(&bar[XB_TOP], 1u);
            const unsigned tg = og / nx;
            if (og + 1u == (tg + 1u) * nx) xb_add(&bar[XB_TOPGEN], 1u);
            else XB_SPIN(xb_ld(&bar[XB_TOPGEN]) == tg, bar);
            __builtin_amdgcn_fence(__ATOMIC_ACQUIRE, "agent");
            xb_add(&bar[XB_XGEN(b.x)], 1u);
            asm volatile("s_waitcnt vmcnt(0)" ::: "memory");
        } else {
            XB_SPIN(xb_ld(&bar[XB_XGEN(b.x)]) == gen, bar);
            __builtin_amdgcn_fence(__ATOMIC_ACQUIRE, "agent");
            asm volatile("s_waitcnt vmcnt(0)" ::: "memory");
        }
    }
    __syncthreads();
}

__global__ void __launch_bounds__(256, 2) mega_fwd(Params p) {
    extern __shared__ __attribute__((aligned(16))) unsigned char smem[];
    cg::grid_group grid = cg::this_grid();
    unsigned char* ws = p.ws;
    const u16* Wb = (const u16*)(ws + OFF_W);
    const u16* HO = (const u16*)(ws + OFF_HO);
    unsigned* bar = (unsigned*)(ws + OFF_BAR);
    XcdBarrier xb = xcd_barrier_post(bar);

    for (int rep = 0; rep < REP_P0; ++rep) { if (rep) grid.sync(); phase0(p, smem); }
    grid.sync();
    rownorm_phase(p, 0, 0);
    xcd_barrier(xb);
#pragma unroll 1
    for (int l = 0; l < 4; ++l) {
        const bool last = (l == 3);
        if ((l & 1) == 0) {
            const int e = l >> 1;
            for (int rep = 0; rep < REP_GEMM; ++rep) { if (rep) xcd_barrier(xb); gemm_phase<EPI_EIN>(p, l, HO, DM, Wb + W_EIN + (size_t)e * 1280 * 1024, 1024, 10, false, smem); }
            xcd_barrier(xb);
            {
                const int tq = 288 * 6, tkv = 288 * 8;
                for (int rep = 0; rep < REP_GEMM; ++rep) { if (rep) xcd_barrier(xb);
                for (int r = 0;; ++r) {
                    int mt, nt;
                    if (!tile_order(r, tq, 6, mt, nt)) break;
                    gemm_tile<EPI_UQ>(p, l, (const u16*)(ws + P_CQ), 256, Wb + W_UQ + (size_t)e * 768 * 256, 256, mt * 128, nt * 128, smem);
                }
                for (int r = 0;; ++r) {
                    int mt, nt;
                    if (!tile_order(r, tkv, 8, mt, nt)) break;
                    gemm_tile<EPI_UKV>(p, l, (const u16*)(ws + P_CKV), 128, Wb + W_UKV + (size_t)e * 1024 * 128, 128, mt * 128, nt * 128, smem);
                }
                }
            }
            xcd_barrier(xb);
            for (int rep = 0; rep < REP_ATTN; ++rep) { if (rep) xcd_barrier(xb); attn_even_phase(p, l, smem); }
            xcd_barrier(xb);
            for (int rep = 0; rep < REP_GEMM; ++rep) { if (rep) xcd_barrier(xb); gemm_phase3<EPI_Y>(p, l, HO, DM, Wb + W_EOUT + (size_t)e * 1024 * 1024, 1024, 8, last, smem); }
        } else {
            const int o = l >> 1;
            for (int rep = 0; rep < REP_GEMM; ++rep) { if (rep) xcd_barrier(xb); gemm_phase<EPI_OIN>(p, l, HO, DM, Wb + W_OIN + (size_t)o * 2304 * 1024, 1024, 18, false, smem); }
            xcd_barrier(xb);
            for (int rep = 0; rep < REP_ATTN; ++rep) { if (rep) xcd_barrier(xb); attn_odd_phase(p, l, smem); }
            xcd_barrier(xb);
            for (int rep = 0; rep < REP_GEMM; ++rep) { if (rep) xcd_barrier(xb); gemm_phase3<EPI_Y>(p, l, HO, DM, Wb + W_OOUT + (size_t)o * 1024 * 1024, 1024, 8, last, smem); }
        }
        xcd_barrier(xb);
        rownorm_phase(p, 1, l);
        xcd_barrier(xb);
        for (int rep = 0; rep < REP_GEMM; ++rep) { if (rep) xcd_barrier(xb); gemm_phase3<EPI_FFN1>(p, l, HO, DM, Wb + W_FFN1 + (size_t)l * 5632 * 1024, 1024, 44, last, smem); }
        xcd_barrier(xb);
        for (int rep = 0; rep < REP_GEMM; ++rep) { if (rep) xcd_barrier(xb); gemm_phase3<EPI_Y>(p, l, (const u16*)(ws + OFF_ACT), FFH, Wb + W_FFN2 + (size_t)l * 1024 * 2816, 2816, 8, last, smem); }
        xcd_barrier(xb);
        rownorm_phase(p, 2, l);
        if (!last) xcd_barrier(xb);
    }
}

extern "C" void kernel_launch(void* const* d_in, const int* in_sizes, int n_in, void* d_out, int out_size, void* d_ws, size_t ws_size, hipStream_t stream) {
    static int grid_blocks = 0;
    if (grid_blocks == 0) {
        if (n_in != 21 || ws_size < WS_TOTAL) { fprintf(stderr, "kernel_launch: unexpected n_in %d or ws_size %zu (< %zu)\n", n_in, ws_size, (size_t)WS_TOTAL); grid_blocks = -1; return; }
        int dev = 0, cus = 0, per_cu = 0;
        hipGetDevice(&dev);
        hipDeviceGetAttribute(&cus, hipDeviceAttributeMultiprocessorCount, dev);
        if (hipFuncSetAttribute((const void*)mega_fwd, hipFuncAttributeMaxDynamicSharedMemorySize, LDS_BYTES) != hipSuccess) { fprintf(stderr, "kernel_launch: hipFuncSetAttribute failed\n"); grid_blocks = -1; return; }
        if (hipOccupancyMaxActiveBlocksPerMultiprocessor(&per_cu, (const void*)mega_fwd, 256, LDS_BYTES) != hipSuccess || per_cu < 1) { fprintf(stderr, "kernel_launch: occupancy query failed (%d)\n", per_cu); per_cu = 1; (void)hipGetLastError(); }
        if (per_cu > 2) per_cu = 2;
        grid_blocks = cus * per_cu;
    }
    if (grid_blocks < 0) return;
    Params p{};
    p.x = (const float*)d_in[0]; p.c = (const float*)d_in[1]; p.ctx = (const float*)d_in[2]; p.c_ctx = (const float*)d_in[3];
    p.ada_w = (const float*)d_in[4]; p.ada_b = (const float*)d_in[5]; p.norm_g = (const float*)d_in[6];
    p.ffn_w_in = (const float*)d_in[7]; p.ffn_w_out = (const float*)d_in[8];
    p.ev_w_in = (const float*)d_in[9]; p.ev_sink = (const float*)d_in[10]; p.ev_q_norm = (const float*)d_in[11]; p.ev_w_uq = (const float*)d_in[12];
    p.ev_kv_norm = (const float*)d_in[13]; p.ev_w_ukv = (const float*)d_in[14]; p.ev_w_out = (const float*)d_in[15];
    p.od_w_in = (const float*)d_in[16]; p.od_qk_norm = (const float*)d_in[17]; p.od_lambda = (const float*)d_in[18]; p.od_subln = (const float*)d_in[19]; p.od_w_out = (const float*)d_in[20];
    p.out = (float*)d_out; p.ws = (unsigned char*)d_ws;
    if (hipMemsetAsync((unsigned char*)d_ws + OFF_BAR, 0, 16384, stream) != hipSuccess) { fprintf(stderr, "kernel_launch: memset of barrier words failed\n"); return; }
    void* args[] = {&p};
    hipError_t e = hipLaunchCooperativeKernel((const void*)mega_fwd, dim3(grid_blocks), dim3(256), args, LDS_BYTES, stream);
    if (e != hipSuccess) fprintf(stderr, "cooperative launch failed: %s (grid %d)\n", hipGetErrorString(e), grid_blocks);
}
```

```cpp
#include <hip/hip_runtime.h>
#include <hip/hip_cooperative_groups.h>
#include <cstdio>
#include <cstdint>
namespace cg = cooperative_groups;
#ifndef REP_GEMM
#define REP_GEMM 1
#endif
#ifndef REP_ATTN
#define REP_ATTN 1
#endif
#ifndef REP_P0
#define REP_P0 1
#endif

typedef unsigned short u16;
typedef short bf16x8 __attribute__((ext_vector_type(8)));
typedef short bf16x4 __attribute__((ext_vector_type(4)));
typedef float f32x4 __attribute__((ext_vector_type(4)));
typedef unsigned u32x4 __attribute__((ext_vector_type(4)));
typedef unsigned u32x2 __attribute__((ext_vector_type(2)));

constexpr int DM = 1024, NBATCH = 16, SEQ = 2048, CTX = 256, TOK = 2304, MR = NBATCH * TOK, FFH = 2816;
constexpr float EPS = 1e-6f;
constexpr float LOG2E = 1.4426950408889634f;
constexpr int LDS_BYTES = 81920;

constexpr size_t al256(size_t x) { return (x + 255) & ~size_t(255); }
constexpr size_t OFF_MOD = 0;
constexpr size_t OFF_R16 = OFF_MOD + al256(4ull * 17 * 6144 * 4);
constexpr size_t OFF_R8 = OFF_R16 + 8192;
constexpr size_t OFF_LAM = OFF_R8 + 4096;
constexpr size_t OFF_XC = OFF_LAM + 256;
constexpr size_t OFF_W = OFF_XC + (size_t)NBATCH * CTX * DM * 4;
constexpr size_t W_FFN1 = 0;
constexpr size_t W_FFN2 = W_FFN1 + 4ull * 5632 * 1024;
constexpr size_t W_EIN = W_FFN2 + 4ull * 1024 * 2816;
constexpr size_t W_UQ = W_EIN + 2ull * 1280 * 1024;
constexpr size_t W_UKV = W_UQ + 2ull * 768 * 256;
constexpr size_t W_EOUT = W_UKV + 2ull * 1024 * 128;
constexpr size_t W_OIN = W_EOUT + 2ull * 1024 * 1024;
constexpr size_t W_OOUT = W_OIN + 2ull * 2304 * 1024;
constexpr size_t W_END = W_OOUT + 2ull * 1024 * 1024;
constexpr size_t OFF_HO = OFF_W + al256(W_END * 2);
constexpr size_t OFF_R1 = OFF_HO + (size_t)MR * DM * 2;
constexpr size_t OFF_ACT = OFF_R1;
constexpr size_t OFF_Y = OFF_ACT + (size_t)MR * FFH * 2;
constexpr size_t WS_END = OFF_Y + (size_t)MR * DM * 2;
constexpr size_t P_QA = OFF_R1;
constexpr size_t P_KA = P_QA + (size_t)MR * 512 * 2;
constexpr size_t P_VAT = P_KA + (size_t)MR * 128 * 2;
constexpr size_t P_CQ = P_VAT + (size_t)MR * 128 * 2;
constexpr size_t P_CKV = P_CQ + (size_t)MR * 256 * 2;
constexpr size_t P_KPE = P_CKV + (size_t)MR * 128 * 2;
constexpr size_t P_SS = P_KPE + (size_t)MR * 32 * 2;
constexpr size_t P_QB = P_SS + (size_t)MR * 8 * 4;
constexpr size_t P_KB = P_QB + (size_t)MR * 768 * 2;
constexpr size_t P_VBT = P_KB + (size_t)MR * 768 * 2;
constexpr size_t P_EEND = P_VBT + (size_t)MR * 512 * 2;
constexpr size_t P_QC = OFF_R1;
constexpr size_t P_KC = P_QC + (size_t)MR * 512 * 2;
constexpr size_t P_VCT = P_KC + (size_t)MR * 128 * 2;
constexpr size_t P_QD = P_VCT + (size_t)MR * 128 * 2;
constexpr size_t P_KD = P_QD + (size_t)MR * 512 * 2;
constexpr size_t P_VDT = P_KD + (size_t)MR * 512 * 2;
constexpr size_t P_OEND = P_VDT + (size_t)MR * 512 * 2;
static_assert(P_EEND <= WS_END && P_OEND <= WS_END, "projection overlay too large");
constexpr size_t OFF_BAR = WS_END;
constexpr size_t WS_TOTAL = WS_END + 16384;
static_assert(WS_TOTAL <= 536870912ull, "workspace too large");

struct Params {
    const float *x, *c, *ctx, *c_ctx, *ada_w, *ada_b, *norm_g, *ffn_w_in, *ffn_w_out;
    const float *ev_w_in, *ev_sink, *ev_q_norm, *ev_w_uq, *ev_kv_norm, *ev_w_ukv, *ev_w_out;
    const float *od_w_in, *od_qk_norm, *od_lambda, *od_subln, *od_w_out;
    float* out;
    unsigned char* ws;
};

typedef float f32x2_t __attribute__((ext_vector_type(2)));
typedef __bf16 bf16x2_t __attribute__((ext_vector_type(2)));
__device__ __forceinline__ unsigned pk2(float lo, float hi) {
    const f32x2_t v = {lo, hi};
    return __builtin_bit_cast(unsigned, __builtin_convertvector(v, bf16x2_t));
}
__device__ __forceinline__ int opaque_tid() { int t = threadIdx.x; asm volatile("" : "+v"(t)); return t; }
__device__ __forceinline__ u16 f2bf(float f) { return (u16)(pk2(f, 0.f) & 0xffffu); }
__device__ __forceinline__ float bf2f(unsigned h) { return __uint_as_float(h << 16); }
__device__ __forceinline__ float wave_sum(float v) {
#pragma unroll
    for (int o = 1; o < 64; o <<= 1) v += __shfl_xor(v, o);
    return v;
}
__device__ __forceinline__ size_t tiled_off(int row, int k, int K) { return ((size_t)(row >> 4) * (K >> 5) + (k >> 5)) * 512 + (row & 15) * 32 + (k & 31); }
__device__ __forceinline__ size_t ktile_off(int t, int d, int NDS) {
    const int p = t & 63, kk = ((p >> 5) << 1) | ((p >> 2) & 1), r = ((p >> 3) & 3) * 4 + (p & 3);
    return ((size_t)(t >> 6) * (4 * NDS) + kk * NDS + (d >> 5)) * 512 + r * 32 + (d & 31);
}
__device__ __forceinline__ size_t vtile_off(int dv, int t, int NI) {
    return ((size_t)(t >> 6) * (2 * NI) + (dv >> 4) * 2 + ((t >> 5) & 1)) * 512 + (dv & 15) * 32 + (t & 31);
}
__device__ __forceinline__ float lam_init_of(int l) { return 0.8f - 0.6f * expf(-0.3f * (float)l); }

__device__ __forceinline__ void ada_item(const Params& p, int it, unsigned char* smem) {
    const int tid = opaque_tid(), lane = tid & 63, wid = tid >> 6;
    const int l = it / 96, n0 = (it % 96) * 64;
    float* S = (float*)smem;
    for (int i = tid; i < 17 * 1024; i += 256) {
        const int r = i >> 10, k = i & 1023;
        const float cv = (r < 16) ? p.c[r * 1024 + k] : p.c_ctx[k];
        S[i] = cv / (1.f + expf(-cv));
    }
    __syncthreads();
    float acc[17];
#pragma unroll
    for (int r = 0; r < 17; ++r) acc[r] = 0.f;
    const float* W = p.ada_w + (size_t)l * 1024 * 6144 + n0 + lane;
    const int kb = wid * 256;
#pragma unroll 2
    for (int k = kb; k < kb + 256; k += 4) {
        const float w0 = W[(size_t)k * 6144], w1 = W[(size_t)(k + 1) * 6144], w2 = W[(size_t)(k + 2) * 6144], w3 = W[(size_t)(k + 3) * 6144];
#pragma unroll
        for (int r = 0; r < 17; ++r) {
            const f32x4 s = *(const f32x4*)&S[r * 1024 + k];
            acc[r] += s[0] * w0 + s[1] * w1 + s[2] * w2 + s[3] * w3;
        }
    }
    __syncthreads();
    float* R = (float*)smem;
#pragma unroll
    for (int r = 0; r < 17; ++r) R[(wid * 17 + r) * 64 + lane] = acc[r];
    __syncthreads();
    float* MOD = (float*)(p.ws + OFF_MOD);
    for (int i = tid; i < 17 * 64; i += 256) {
        const int r = i >> 6, n = i & 63;
        const float v = R[(0 * 17 + r) * 64 + n] + R[(1 * 17 + r) * 64 + n] + R[(2 * 17 + r) * 64 + n] + R[(3 * 17 + r) * 64 + n] + p.ada_b[l * 6144 + n0 + n];
        MOD[((size_t)l * 17 + r) * 6144 + n0 + n] = v;
    }
    __syncthreads();
}

__device__ __forceinline__ void wt_tile(const float* __restrict__ src, u16* __restrict__ dst, const float* __restrict__ ksc, int K, int N, int Npad, int mode, int t, unsigned char* smem) {
    const int tid = opaque_tid();
    const int nT = Npad >> 8;
    const int nt = t % nT, kt = t / nT, n0 = nt * 256, k0 = kt * 64;
    float* T = (float*)smem;
    {
        const int c4 = (tid & 63) * 4, ks = tid >> 6, n = n0 + c4;
#pragma unroll
        for (int i = 0; i < 16; ++i) {
            const int k = i * 4 + ks;
            f32x4 v = (n < N) ? *(const f32x4*)(src + (size_t)(k0 + k) * N + n) : (f32x4){0.f, 0.f, 0.f, 0.f};
            if (ksc) v = v * ksc[k0 + k];
            *(f32x4*)(T + k * 260 + c4) = v;
        }
    }
    __syncthreads();
#pragma unroll
    for (int kq = 0; kq < 4; ++kq) {
        const float* s = T + (kq * 16) * 260 + tid;
        uint4 o0, o1;
        o0.x = pk2(s[0 * 260], s[1 * 260]); o0.y = pk2(s[2 * 260], s[3 * 260]); o0.z = pk2(s[4 * 260], s[5 * 260]); o0.w = pk2(s[6 * 260], s[7 * 260]);
        o1.x = pk2(s[8 * 260], s[9 * 260]); o1.y = pk2(s[10 * 260], s[11 * 260]); o1.z = pk2(s[12 * 260], s[13 * 260]); o1.w = pk2(s[14 * 260], s[15 * 260]);
        int nd = n0 + tid;
        if (mode == 1) nd = (nd < FFH) ? ((nd >> 4) * 32 + (nd & 15)) : ((((nd - FFH) >> 4) * 32) + 16 + ((nd - FFH) & 15));
        *(uint4*)(dst + tiled_off(nd, k0 + kq * 16, K)) = o0;
        *(uint4*)(dst + tiled_off(nd, k0 + kq * 16 + 8, K)) = o1;
    }
    __syncthreads();
}

constexpr int T_FFN1 = 16 * 22, T_FFN2 = 44 * 4, T_EIN = 16 * 5, T_UQ = 4 * 3, T_UKV = 2 * 4, T_OUT = 16 * 4, T_OIN = 16 * 9;
constexpr int NT_ALL = 4 * (T_FFN1 + T_FFN2) + 2 * (T_EIN + T_UQ + T_UKV + T_OUT) + 2 * (T_OIN + T_OUT);
constexpr int N_ADA = 4 * 96;

__device__ __forceinline__ void wt_item(const Params& p, int r, unsigned char* smem) {
    u16* Wb = (u16*)(p.ws + OFF_W);
    if (r < 4 * T_FFN1) { const int l = r / T_FFN1; wt_tile(p.ffn_w_in + (size_t)l * 1024 * 5632, Wb + W_FFN1 + (size_t)l * 5632 * 1024, nullptr, 1024, 5632, 5632, 1, r % T_FFN1, smem); return; }
    r -= 4 * T_FFN1;
    if (r < 4 * T_FFN2) { const int l = r / T_FFN2; wt_tile(p.ffn_w_out + (size_t)l * 2816 * 1024, Wb + W_FFN2 + (size_t)l * 1024 * 2816, nullptr, 2816, 1024, 1024, 0, r % T_FFN2, smem); return; }
    r -= 4 * T_FFN2;
    if (r < 2 * T_EIN) { const int e = r / T_EIN; wt_tile(p.ev_w_in + (size_t)e * 1024 * 1184, Wb + W_EIN + (size_t)e * 1280 * 1024, nullptr, 1024, 1184, 1280, 0, r % T_EIN, smem); return; }
    r -= 2 * T_EIN;
    if (r < 2 * T_UQ) { const int e = r / T_UQ; wt_tile(p.ev_w_uq + (size_t)e * 256 * 768, Wb + W_UQ + (size_t)e * 768 * 256, p.ev_q_norm + e * 256, 256, 768, 768, 0, r % T_UQ, smem); return; }
    r -= 2 * T_UQ;
    if (r < 2 * T_UKV) { const int e = r / T_UKV; wt_tile(p.ev_w_ukv + (size_t)e * 128 * 1024, Wb + W_UKV + (size_t)e * 1024 * 128, p.ev_kv_norm + e * 128, 128, 1024, 1024, 0, r % T_UKV, smem); return; }
    r -= 2 * T_UKV;
    if (r < 2 * T_OUT) { const int e = r / T_OUT; wt_tile(p.ev_w_out + (size_t)e * 1024 * 1024, Wb + W_EOUT + (size_t)e * 1024 * 1024, nullptr, 1024, 1024, 1024, 0, r % T_OUT, smem); return; }
    r -= 2 * T_OUT;
    if (r < 2 * T_OIN) { const int o = r / T_OIN; wt_tile(p.od_w_in + (size_t)o * 1024 * 2304, Wb + W_OIN + (size_t)o * 2304 * 1024, nullptr, 1024, 2304, 2304, 0, r % T_OIN, smem); return; }
    r -= 2 * T_OIN;
    { const int o = r / T_OUT; wt_tile(p.od_w_out + (size_t)o * 1024 * 1024, Wb + W_OOUT + (size_t)o * 1024 * 1024, nullptr, 1024, 1024, 1024, 0, r % T_OUT, smem); }
}

__device__ __forceinline__ void misc_item(const Params& p) {
    const int tid = opaque_tid(), lane = tid & 63, wid = tid >> 6;
    float* R16 = (float*)(p.ws + OFF_R16);
    float* R8 = (float*)(p.ws + OFF_R8);
    for (int i = tid; i < 1024; i += 256) {
        const int pos = i >> 4, fi = i & 15;
        const float f = powf(10000.f, -(float)fi / 16.f), a = (float)pos * f;
        R16[2 * i] = cosf(a); R16[2 * i + 1] = sinf(a);
    }
    for (int i = tid; i < 512; i += 256) {
        const int pos = i >> 3, fi = i & 7;
        const float f = powf(10000.f, -(float)fi / 8.f), a = (float)pos * f;
        R8[2 * i] = cosf(a); R8[2 * i + 1] = sinf(a);
    }
    if (wid < 2) {
        const float* lp = p.od_lambda + wid * 256;
        const float sa = wave_sum(lp[lane] * lp[64 + lane]);
        const float sb = wave_sum(lp[128 + lane] * lp[192 + lane]);
        if (lane == 0) ((float*)(p.ws + OFF_LAM))[wid] = expf(sa) - expf(sb) + lam_init_of(2 * wid + 1);
    }
}

__device__ __forceinline__ void phase0(const Params& p, unsigned char* smem) {
    constexpr int TOTAL = N_ADA + NT_ALL + 1;
    for (int it = blockIdx.x; it < TOTAL; it += gridDim.x) {
        if (it < N_ADA) ada_item(p, it, smem);
        else if (it < N_ADA + NT_ALL) wt_item(p, it - N_ADA, smem);
        else misc_item(p);
    }
}

__device__ __forceinline__ f32x4 bf4_to_f32(u32x2 y) {
    f32x4 r; r[0] = bf2f(y[0] & 0xffffu); r[1] = __uint_as_float(y[0] & 0xffff0000u); r[2] = bf2f(y[1] & 0xffffu); r[3] = __uint_as_float(y[1] & 0xffff0000u);
    return r;
}
__device__ __forceinline__ float dot4(f32x4 a) { return a[0] * a[0] + a[1] * a[1] + a[2] * a[2] + a[3] * a[3]; }
__device__ __forceinline__ void rownorm_phase(const Params& p, int mode, int l) {
    const int tid = opaque_tid(), lane = tid & 63, wid = tid >> 6;
    const float* MOD = (const float*)(p.ws + OFF_MOD);
    float* XC = (float*)(p.ws + OFF_XC);
    u16* H = (u16*)(p.ws + OFF_HO);
    const u16* Y = (const u16*)(p.ws + OFF_Y);
    const bool makeH = !(mode == 2 && l == 3);
    const int lh = (mode == 2) ? l + 1 : l;
    const int hsh = (mode == 1) ? 3 : 0, hsc = (mode == 1) ? 4 : 1, hg = (mode == 1) ? 2 : 0;
    const int ug = (mode == 1) ? 2 : 5, ugam = (mode == 1) ? 1 : 3;
    const int col0 = lane * 4;
    for (int ch = blockIdx.x * 4 + wid; ch < MR / 4; ch += gridDim.x * 4) {
        const int row0 = ch * 4;
        const int b = row0 / TOK, t0 = row0 - b * TOK;
        const bool isctx = t0 < CTX;
        if (l == 3 && mode != 0 && isctx) continue;
        const int mb = isctx ? 16 : b;
        float* xp = isctx ? XC + ((size_t)(b * CTX + t0)) * DM : p.out + ((size_t)(b * SEQ + t0 - CTX)) * DM;
        f32x4 xv[4][4];
        if (mode == 0) {
            const float* src = isctx ? p.ctx + ((size_t)(b * CTX + t0)) * DM : p.x + ((size_t)(b * SEQ + t0 - CTX)) * DM;
#pragma unroll
            for (int r = 0; r < 4; ++r)
#pragma unroll
                for (int c = 0; c < 4; ++c) xv[r][c] = *(const f32x4*)(src + (size_t)r * DM + c * 256 + col0);
        } else {
            u32x2 yr[4][4];
#pragma unroll
            for (int r = 0; r < 4; ++r)
#pragma unroll
                for (int c = 0; c < 4; ++c) {
                    xv[r][c] = __builtin_nontemporal_load((const f32x4*)(xp + (size_t)r * DM + c * 256 + col0));
                    yr[r][c] = *(const u32x2*)(Y + (size_t)(row0 + r) * DM + c * 256 + col0);
                }
            const float* gate = MOD + ((size_t)l * 17 + mb) * 6144 + ug * 1024;
            const float* gam = p.norm_g + ((size_t)l * 4 + ugam) * DM;
            f32x4 gg[4];
#pragma unroll
            for (int c = 0; c < 4; ++c) gg[c] = *(const f32x4*)(gate + c * 256 + col0) * *(const f32x4*)(gam + c * 256 + col0);
            float ss[4];
#pragma unroll
            for (int r = 0; r < 4; ++r) {
                float s = 0.f;
#pragma unroll
                for (int c = 0; c < 4; ++c) s += dot4(bf4_to_f32(yr[r][c]));
                ss[r] = s;
            }
#pragma unroll
            for (int o = 1; o < 64; o <<= 1) {
#pragma unroll
                for (int r = 0; r < 4; ++r) ss[r] += __shfl_xor(ss[r], o);
            }
#pragma unroll
            for (int r = 0; r < 4; ++r) {
                const float rinv = rsqrtf(ss[r] * (1.f / DM) + EPS);
#pragma unroll
                for (int c = 0; c < 4; ++c) xv[r][c] = xv[r][c] + gg[c] * (bf4_to_f32(yr[r][c]) * rinv);
            }
        }
#pragma unroll
        for (int r = 0; r < 4; ++r)
#pragma unroll
            for (int c = 0; c < 4; ++c) __builtin_nontemporal_store(xv[r][c], (f32x4*)(xp + (size_t)r * DM + c * 256 + col0));
        if (makeH) {
            float ss[4];
#pragma unroll
            for (int r = 0; r < 4; ++r) {
                float s = 0.f;
#pragma unroll
                for (int c = 0; c < 4; ++c) s += dot4(xv[r][c]);
                ss[r] = s;
            }
#pragma unroll
            for (int o = 1; o < 64; o <<= 1) {
#pragma unroll
                for (int r = 0; r < 4; ++r) ss[r] += __shfl_xor(ss[r], o);
            }
            const float* mrow = MOD + ((size_t)lh * 17 + mb) * 6144;
            const float* gam = p.norm_g + ((size_t)lh * 4 + hg) * DM;
#pragma unroll
            for (int c = 0; c < 4; ++c) {
                const int col = c * 256 + col0;
                const f32x4 sh = *(const f32x4*)(mrow + hsh * 1024 + col);
                const f32x4 sc = *(const f32x4*)(mrow + hsc * 1024 + col);
                const f32x4 gs = *(const f32x4*)(gam + col) * (sc + 1.f);
#pragma unroll
                for (int r = 0; r < 4; ++r) {
                    const float rinv = rsqrtf(ss[r] * (1.f / DM) + EPS);
                    const f32x4 hv = (xv[r][c] * rinv) * gs + sh;
                    u32x2 o; o[0] = pk2(hv[0], hv[1]); o[1] = pk2(hv[2], hv[3]);
                    *(u32x2*)(H + tiled_off(row0 + r, col, DM)) = o;
                }
            }
        }
    }
}

enum { EPI_EIN = 0, EPI_UQ = 1, EPI_UKV = 2, EPI_OIN = 3, EPI_Y = 4, EPI_FFN1 = 5 };

__device__ __forceinline__ void rope64(float (&v)[64], const float* R16, int t) {
    if (t < CTX) return;
    const int pp = t - CTX, pr = pp >> 6, pc = pp & 63;
    const float2* tr = (const float2*)R16 + pr * 16;
    const float2* tc = (const float2*)R16 + pc * 16;
#pragma unroll
    for (int i = 0; i < 16; ++i) {
        const float2 cs = tr[i];
        const float a = v[i], bb = v[i + 16];
        v[i] = a * cs.x - bb * cs.y; v[i + 16] = bb * cs.x + a * cs.y;
    }
#pragma unroll
    for (int i = 0; i < 16; ++i) {
        const float2 cs = tc[i];
        const float a = v[32 + i], bb = v[48 + i];
        v[32 + i] = a * cs.x - bb * cs.y; v[48 + i] = bb * cs.x + a * cs.y;
    }
}
template <int O>
__device__ __forceinline__ void rope32(float (&v)[64], const float* R8, int t) {
    if (t < CTX) return;
    const int pp = t - CTX, pr = pp >> 6, pc = pp & 63;
    const float2* tr = (const float2*)R8 + pr * 8;
    const float2* tc = (const float2*)R8 + pc * 8;
#pragma unroll
    for (int i = 0; i < 8; ++i) {
        const float2 cs = tr[i];
        const float a = v[O + i], bb = v[O + i + 8];
        v[O + i] = a * cs.x - bb * cs.y; v[O + i + 8] = bb * cs.x + a * cs.y;
    }
#pragma unroll
    for (int i = 0; i < 8; ++i) {
        const float2 cs = tc[i];
        const float a = v[O + 16 + i], bb = v[O + 24 + i];
        v[O + 16 + i] = a * cs.x - bb * cs.y; v[O + 24 + i] = bb * cs.x + a * cs.y;
    }
}
template <int N>
__device__ __forceinline__ void store_row(u16* dst, const float (&v)[64]) {
#pragma unroll
    for (int c = 0; c < N; c += 8) {
        uint4 o; o.x = pk2(v[c], v[c + 1]); o.y = pk2(v[c + 2], v[c + 3]); o.z = pk2(v[c + 4], v[c + 5]); o.w = pk2(v[c + 6], v[c + 7]);
        *(uint4*)(dst + c) = o;
    }
}
__device__ __forceinline__ void store_row_tiled64(u16* base, int row, int k0, int K, const float (&v)[64]) {
#pragma unroll
    for (int c = 0; c < 64; c += 8) {
        uint4 o; o.x = pk2(v[c], v[c + 1]); o.y = pk2(v[c + 2], v[c + 3]); o.z = pk2(v[c + 4], v[c + 5]); o.w = pk2(v[c + 6], v[c + 7]);
        *(uint4*)(base + tiled_off(row, k0 + c, K)) = o;
    }
}
__device__ __forceinline__ void store_k64(u16* head, int t, int d0, int NDS, const float (&v)[64]) {
#pragma unroll
    for (int c = 0; c < 64; c += 8) {
        uint4 o; o.x = pk2(v[c], v[c + 1]); o.y = pk2(v[c + 2], v[c + 3]); o.z = pk2(v[c + 4], v[c + 5]); o.w = pk2(v[c + 6], v[c + 7]);
        *(uint4*)(head + ktile_off(t, d0 + c, NDS)) = o;
    }
}
__device__ __forceinline__ void store_v64(u16* head, int dv0, int t, int NI, const float (&v)[64]) {
#pragma unroll
    for (int c = 0; c < 64; ++c) head[vtile_off(dv0 + c, t, NI)] = f2bf(v[c]);
}
__device__ __forceinline__ void store_T64(u16* dst, const float (&v)[64]) {
#pragma unroll
    for (int c = 0; c < 64; ++c) dst[(size_t)c * TOK] = f2bf(v[c]);
}
__device__ __forceinline__ float sumsq64(const float (&v)[64]) {
    float s = 0.f;
#pragma unroll
    for (int c = 0; c < 64; ++c) s += v[c] * v[c];
    return s;
}

template <int EPI>
__device__ __forceinline__ void epi_seg(const Params& p, int l, int row, int b, int t, int seg, float (&v)[64]) {
    unsigned char* ws = p.ws;
    const float* R16 = (const float*)(ws + OFF_R16);
    const float* R8 = (const float*)(ws + OFF_R8);
    if (EPI == EPI_EIN) {
        if (seg < 8) { rope64(v, R16, t); store_row<64>((u16*)(ws + P_QA) + (size_t)row * 512 + seg * 64, v); }
        else if (seg < 10) { rope64(v, R16, t); store_k64((u16*)(ws + P_KA) + ((size_t)(b * 2 + seg - 8) * TOK) * 64, t, 0, 2, v); }
        else if (seg < 12) { store_v64((u16*)(ws + P_VAT) + ((size_t)(b * 2 + seg - 10) * 64) * TOK, 0, t, 4, v); }
        else if (seg < 16) { ((float*)(ws + P_SS))[(size_t)row * 8 + seg - 12] = sumsq64(v); store_row_tiled64((u16*)(ws + P_CQ), row, (seg - 12) * 64, 256, v); }
        else if (seg < 18) { ((float*)(ws + P_SS))[(size_t)row * 8 + 4 + seg - 16] = sumsq64(v); store_row_tiled64((u16*)(ws + P_CKV), row, (seg - 16) * 64, 128, v); }
        else if (seg == 18) { rope32<0>(v, R8, t); store_row<32>((u16*)(ws + P_KPE) + (size_t)row * 32, v); }
    } else if (EPI == EPI_UQ) {
        const f32x4 s4 = *(const f32x4*)((const float*)(ws + P_SS) + (size_t)row * 8);
        const float rinv = rsqrtf((s4[0] + s4[1] + s4[2] + s4[3]) * (1.f / 256.f) + EPS);
#pragma unroll
        for (int c = 0; c < 64; ++c) v[c] *= rinv;
        if (((2 * seg) % 3) == 2) rope32<0>(v, R8, t);
        if (((2 * seg + 1) % 3) == 2) rope32<32>(v, R8, t);
        store_row<64>((u16*)(ws + P_QB) + (size_t)row * 768 + seg * 64, v);
    } else if (EPI == EPI_UKV) {
        const float* ssp = (const float*)(ws + P_SS) + (size_t)row * 8;
        const float rinv = rsqrtf((ssp[4] + ssp[5]) * (1.f / 128.f) + EPS);
#pragma unroll
        for (int c = 0; c < 64; ++c) v[c] *= rinv;
        const int h = seg >> 1;
        if ((seg & 1) == 0) {
            u16* kh = (u16*)(ws + P_KB) + ((size_t)(b * 8 + h) * TOK) * 96;
            store_k64(kh, t, 0, 3, v);
            const uint4* kp = (const uint4*)((const u16*)(ws + P_KPE) + (size_t)row * 32);
#pragma unroll
            for (int c = 0; c < 4; ++c) *(uint4*)(kh + ktile_off(t, 64 + c * 8, 3)) = kp[c];
        } else {
            store_v64((u16*)(ws + P_VBT) + ((size_t)(b * 8 + h) * 64) * TOK, 0, t, 4, v);
        }
    } else if (EPI == EPI_OIN) {
        const int o = l >> 1;
        if (seg < 10) {
            const float* g = p.od_qk_norm + (size_t)o * 128 + (seg < 8 ? 0 : 64);
            const float rinv = rsqrtf(sumsq64(v) * (1.f / 64.f) + EPS);
#pragma unroll
            for (int c = 0; c < 64; ++c) v[c] = v[c] * rinv * g[c];
            rope64(v, R16, t);
            if (seg < 8) store_row<64>((u16*)(ws + P_QC) + (size_t)row * 512 + seg * 64, v);
            else store_k64((u16*)(ws + P_KC) + ((size_t)(b * 2 + seg - 8) * TOK) * 64, t, 0, 2, v);
        } else if (seg < 12) { store_v64((u16*)(ws + P_VCT) + ((size_t)(b * 2 + seg - 10) * 64) * TOK, 0, t, 4, v); }
        else if (seg < 20) { rope64(v, R16, t); store_row<64>((u16*)(ws + P_QD) + (size_t)row * 512 + (seg - 12) * 64, v); }
        else if (seg < 28) { rope64(v, R16, t); store_k64((u16*)(ws + P_KD) + ((size_t)(b * 8 + seg - 20) * TOK) * 64, t, 0, 2, v); }
        else { const int s2 = seg - 28; store_v64((u16*)(ws + P_VDT) + ((size_t)(b * 4 + (s2 >> 1)) * 128) * TOK, (s2 & 1) * 64, t, 8, v); }
    } else if (EPI == EPI_Y) {
        store_row<64>((u16*)(ws + OFF_Y) + (size_t)row * DM + seg * 64, v);
    }
}

template <int EPI, int ROWS>
__device__ __forceinline__ void epi_process(const Params& p, int l, int m0, int n0, const float* Cs, int tid) {
    if (EPI == EPI_FFN1) {
        const int c8 = (tid & 7) * 8;
        u16* dst = (u16*)(p.ws + OFF_ACT) + (size_t)m0 * FFH + (n0 >> 7) * 64 + c8;
#pragma unroll
        for (int ps = 0; ps < ROWS / 32; ++ps) {
            const int rl = ps * 32 + (tid >> 3);
            const f32x4 g0 = *(const f32x4*)(Cs + rl * 132 + c8), g1 = *(const f32x4*)(Cs + rl * 132 + c8 + 4);
            const f32x4 u0 = *(const f32x4*)(Cs + rl * 132 + 64 + c8), u1 = *(const f32x4*)(Cs + rl * 132 + 64 + c8 + 4);
            float o[8];
#pragma unroll
            for (int c = 0; c < 4; ++c) { o[c] = g0[c] / (1.f + __expf(-g0[c])) * u0[c]; o[4 + c] = g1[c] / (1.f + __expf(-g1[c])) * u1[c]; }
            u32x4 w; w[0] = pk2(o[0], o[1]); w[1] = pk2(o[2], o[3]); w[2] = pk2(o[4], o[5]); w[3] = pk2(o[6], o[7]);
            *(u32x4*)(dst + (size_t)rl * FFH) = w;
        }
    } else if (EPI == EPI_Y) {
        const int c8 = (tid & 15) * 8;
        u16* dst = (u16*)(p.ws + OFF_Y) + (size_t)m0 * DM + n0 + c8;
#pragma unroll
        for (int ps = 0; ps < ROWS / 16; ++ps) {
            const int rl = ps * 16 + (tid >> 4);
            const f32x4 v0 = *(const f32x4*)(Cs + rl * 132 + c8), v1 = *(const f32x4*)(Cs + rl * 132 + c8 + 4);
            u32x4 w; w[0] = pk2(v0[0], v0[1]); w[1] = pk2(v0[2], v0[3]); w[2] = pk2(v1[0], v1[1]); w[3] = pk2(v1[2], v1[3]);
            *(u32x4*)(dst + (size_t)rl * DM) = w;
        }
    } else {
        if (tid < 2 * ROWS) {
            const int sl = tid / ROWS, rl = tid - sl * ROWS;
            const int row = m0 + rl;
            float v[64];
#pragma unroll
            for (int c = 0; c < 64; ++c) v[c] = Cs[rl * 129 + sl * 64 + c];
            const int b = row / TOK, t = row - b * TOK;
            epi_seg<EPI>(p, l, row, b, t, (n0 >> 6) + sl, v);
        }
    }
}

template <int EPI>
__device__ __forceinline__ void gemm_tile(const Params& p, int l, const u16* __restrict__ A, int lda, const u16* __restrict__ Bt, int K, int m0, int n0, unsigned char* smem) {
    const int tid = opaque_tid(), lane = tid & 63, wid = tid >> 6, wr = wid >> 1, wc = wid & 1, fr = lane & 15, fq = lane >> 4;
    f32x4 acc[4][4];
#pragma unroll
    for (int i = 0; i < 4; ++i)
#pragma unroll
        for (int j = 0; j < 4; ++j) acc[i][j] = (f32x4){0.f, 0.f, 0.f, 0.f};
    const unsigned voff = (unsigned)(lane * 16);
    const size_t ksub = (size_t)(K >> 5) * 1024;
    const unsigned char* Abase = (const unsigned char*)A + (size_t)(m0 >> 4) * ksub;
    const unsigned char* Bbase = (const unsigned char*)Bt + (size_t)(n0 >> 4) * ksub;
    (void)lda;
#define GLDS16(gp, lp) __builtin_amdgcn_global_load_lds((const unsigned*)(gp), (unsigned*)(lp), 16, 0, 0)
#define G_TILE(kt_, st_) do { const size_t ko_ = (size_t)(kt_) * 1024; unsigned char* d_ = smem + (st_) * 16384; \
        _Pragma("unroll") for (int s_ = 0; s_ < 8; ++s_) GLDS16(Abase + (size_t)s_ * ksub + ko_ + voff, d_ + s_ * 1024); \
        _Pragma("unroll") for (int s_ = 0; s_ < 8; ++s_) GLDS16(Bbase + (size_t)s_ * ksub + ko_ + voff, d_ + 8192 + s_ * 1024); } while (0)
    const int nk = K >> 5;
    G_TILE(wid, wid);
    const unsigned char* fa = smem + (wr * 4) * 1024 + fr * 64 + fq * 16;
    const unsigned char* fb = smem + 8192 + (wc * 4) * 1024 + fr * 64 + fq * 16;
    int st = 0, stn = 4;
    if (wid == 0) asm volatile("s_waitcnt vmcnt(0)" ::: "memory");
    __builtin_amdgcn_s_barrier();
    asm volatile("" ::: "memory");
    for (int kt = 0; kt < nk; ++kt) {
        if (((kt + 1) & 3) == wid && kt + 1 < nk) asm volatile("s_waitcnt vmcnt(0)" ::: "memory");
        __builtin_amdgcn_s_barrier();
        asm volatile("" ::: "memory");
        if ((kt & 3) == wid && kt + 4 < nk) G_TILE(kt + 4, stn);
        const int so = st * 16384;
        bf16x8 af[4], bv[4];
#pragma unroll
        for (int i = 0; i < 4; ++i) af[i] = *(const bf16x8*)(fa + so + i * 1024);
#pragma unroll
        for (int j = 0; j < 4; ++j) bv[j] = *(const bf16x8*)(fb + so + j * 1024);
        __builtin_amdgcn_s_setprio(1);
#pragma unroll
        for (int i = 0; i < 4; ++i)
#pragma unroll
            for (int j = 0; j < 4; ++j) acc[i][j] = __builtin_amdgcn_mfma_f32_16x16x32_bf16(af[i], bv[j], acc[i][j], 0, 0, 0);
        __builtin_amdgcn_s_setprio(0);
        st = (st == 4) ? 0 : st + 1;
        stn = (stn == 4) ? 0 : stn + 1;
    }
    __syncthreads();
    float* Cs = (float*)smem;
    constexpr int CS = (EPI == EPI_FFN1 || EPI == EPI_Y) ? 132 : 129;
#pragma unroll
    for (int i = 0; i < 4; ++i)
#pragma unroll
        for (int j = 0; j < 4; ++j)
#pragma unroll
            for (int r = 0; r < 4; ++r) Cs[(wr * 64 + i * 16 + fq * 4 + r) * CS + wc * 64 + j * 16 + fr] = acc[i][j][r];
    __syncthreads();
    epi_process<EPI, 128>(p, l, m0, n0, Cs, tid);
    __syncthreads();
}

template <int EPI>
__device__ __forceinline__ void gemm_tile3(const Params& p, int l, const u16* __restrict__ A, int lda, const u16* __restrict__ Bt, int K, int m0, int n0, unsigned char* smem) {
    const int tid = opaque_tid(), lane = tid & 63, wid = tid >> 6, wr = wid >> 1, wc = wid & 1, fr = lane & 15, fq = lane >> 4;
    f32x4 acc[6][4];
#pragma unroll
    for (int i = 0; i < 6; ++i)
#pragma unroll
        for (int j = 0; j < 4; ++j) acc[i][j] = (f32x4){0.f, 0.f, 0.f, 0.f};
    const unsigned voff = (unsigned)(lane * 16);
    const size_t ksub = (size_t)(K >> 5) * 1024;
    const unsigned char* Abase = (const unsigned char*)A + (size_t)(m0 >> 4) * ksub;
    const unsigned char* Bbase = (const unsigned char*)Bt + (size_t)(n0 >> 4) * ksub;
    (void)lda;
#define G3_TILE(kt_, st_) do { const size_t ko_ = (size_t)(kt_) * 1024; unsigned char* d_ = smem + (st_) * 20480; \
        _Pragma("unroll") for (int s_ = 0; s_ < 12; ++s_) GLDS16(Abase + (size_t)s_ * ksub + ko_ + voff, d_ + s_ * 1024); \
        _Pragma("unroll") for (int s_ = 0; s_ < 8; ++s_) GLDS16(Bbase + (size_t)s_ * ksub + ko_ + voff, d_ + 12288 + s_ * 1024); } while (0)
    const int nk = K >> 5;
    if (wid < 3) G3_TILE(wid, wid);
    const unsigned char* fa = smem + (wr * 6) * 1024 + fr * 64 + fq * 16;
    const unsigned char* fb = smem + 12288 + (wc * 4) * 1024 + fr * 64 + fq * 16;
    int st = 0, stn = 3;
    if (wid == 0) asm volatile("s_waitcnt vmcnt(0)" ::: "memory");
    asm volatile("s_waitcnt lgkmcnt(0)" ::: "memory");
    __builtin_amdgcn_s_barrier();
    asm volatile("" ::: "memory");
    for (int kt = 0; kt < nk; ++kt) {
        if (((kt + 1) & 3) == wid && kt + 1 < nk) asm volatile("s_waitcnt vmcnt(0)" ::: "memory");
        __builtin_amdgcn_s_barrier();
        asm volatile("" ::: "memory");
        if (((kt + 3) & 3) == wid && kt + 3 < nk) G3_TILE(kt + 3, stn);
        const int so = st * 20480;
        bf16x8 af[6], bv[4];
        {
            typedef __attribute__((address_space(3))) unsigned char lds_u8;
            const unsigned la = (unsigned)(uintptr_t)(lds_u8*)(fa + so);
            const unsigned lb = (unsigned)(uintptr_t)(lds_u8*)(fb + so);
#define DSR128(dst_, addr_, off_) asm volatile("ds_read_b128 %0, %1 offset:" #off_ : "=v"(dst_) : "v"(addr_))
            DSR128(bv[0], lb, 0); DSR128(bv[1], lb, 1024); DSR128(bv[2], lb, 2048); DSR128(bv[3], lb, 3072);
            DSR128(af[0], la, 0); DSR128(af[1], la, 1024); DSR128(af[2], la, 2048); DSR128(af[3], la, 3072); DSR128(af[4], la, 4096); DSR128(af[5], la, 5120);
        }
        __builtin_amdgcn_sched_barrier(0);
        asm volatile("s_waitcnt lgkmcnt(5)" : "+v"(bv[0]), "+v"(bv[1]), "+v"(bv[2]), "+v"(bv[3]), "+v"(af[0]));
        __builtin_amdgcn_sched_barrier(0);
#pragma unroll
        for (int j = 0; j < 4; ++j) acc[0][j] = __builtin_amdgcn_mfma_f32_16x16x32_bf16(bv[j], af[0], acc[0][j], 0, 0, 0);
        __builtin_amdgcn_sched_barrier(0);
        asm volatile("s_waitcnt lgkmcnt(4)" : "+v"(af[1]));
        __builtin_amdgcn_sched_barrier(0);
#pragma unroll
        for (int j = 0; j < 4; ++j) acc[1][j] = __builtin_amdgcn_mfma_f32_16x16x32_bf16(bv[j], af[1], acc[1][j], 0, 0, 0);
        __builtin_amdgcn_sched_barrier(0);
        asm volatile("s_waitcnt lgkmcnt(3)" : "+v"(af[2]));
        __builtin_amdgcn_sched_barrier(0);
#pragma unroll
        for (int j = 0; j < 4; ++j) acc[2][j] = __builtin_amdgcn_mfma_f32_16x16x32_bf16(bv[j], af[2], acc[2][j], 0, 0, 0);
        __builtin_amdgcn_sched_barrier(0);
        asm volatile("s_waitcnt lgkmcnt(2)" : "+v"(af[3]));
        __builtin_amdgcn_sched_barrier(0);
#pragma unroll
        for (int j = 0; j < 4; ++j) acc[3][j] = __builtin_amdgcn_mfma_f32_16x16x32_bf16(bv[j], af[3], acc[3][j], 0, 0, 0);
        __builtin_amdgcn_sched_barrier(0);
        asm volatile("s_waitcnt lgkmcnt(1)" : "+v"(af[4]));
        __builtin_amdgcn_sched_barrier(0);
#pragma unroll
        for (int j = 0; j < 4; ++j) acc[4][j] = __builtin_amdgcn_mfma_f32_16x16x32_bf16(bv[j], af[4], acc[4][j], 0, 0, 0);
        __builtin_amdgcn_sched_barrier(0);
        asm volatile("s_waitcnt lgkmcnt(0)" : "+v"(af[5]));
        __builtin_amdgcn_sched_barrier(0);
#pragma unroll
        for (int j = 0; j < 4; ++j) acc[5][j] = __builtin_amdgcn_mfma_f32_16x16x32_bf16(bv[j], af[5], acc[5][j], 0, 0, 0);
        st = (st + 1) & 3;
        stn = (stn + 1) & 3;
    }
    __syncthreads();
    static_assert(EPI == EPI_FFN1 || EPI == EPI_Y, "gemm_tile3 has the plain epilogues only");
    const int rowb = m0 + wr * 96 + fr;
    if (EPI == EPI_Y) {
        u16* dst = (u16*)(p.ws + OFF_Y) + (size_t)rowb * DM + n0 + wc * 64 + fq * 4;
#pragma unroll
        for (int i = 0; i < 6; ++i)
#pragma unroll
            for (int j = 0; j < 4; ++j) {
                u32x2 w; w[0] = pk2(acc[i][j][0], acc[i][j][1]); w[1] = pk2(acc[i][j][2], acc[i][j][3]);
                *(u32x2*)(dst + (size_t)(i * 16) * DM + j * 16) = w;
            }
    } else {
        u16* actb = (u16*)(p.ws + OFF_ACT);
        const int colb = (n0 >> 1) + wc * 32 + fq * 4;
#pragma unroll
        for (int i = 0; i < 6; ++i)
#pragma unroll
            for (int jp = 0; jp < 2; ++jp) {
                float o[4];
#pragma unroll
                for (int r = 0; r < 4; ++r) { const float g = acc[i][2 * jp][r], u = acc[i][2 * jp + 1][r]; o[r] = g / (1.f + __expf(-g)) * u; }
                u32x2 w; w[0] = pk2(o[0], o[1]); w[1] = pk2(o[2], o[3]);
                *(u32x2*)(actb + tiled_off(rowb + i * 16, colb + jp * 16, FFH)) = w;
            }
    }
}

__device__ __forceinline__ bool tile_order(int r, int total, int nN, int& mt, int& nt) {
    const int nloc = gridDim.x >> 3, xcd = blockIdx.x & 7, li = blockIdx.x >> 3;
    const int L = (r * 8 + xcd) * nloc + li;
    if (L >= total) return false;
    const int band = L / (8 * nN), rem = L - band * 8 * nN;
    nt = rem >> 3; mt = band * 8 + (rem & 7);
    return true;
}
template <int EPI>
__device__ __forceinline__ void gemm_phase(const Params& p, int l, const u16* A, int lda, const u16* Bt, int K, int nN, bool skip_ctx, unsigned char* smem) {
    const int nM = skip_ctx ? 256 : 288;
    const int total = nM * nN;
    for (int r = 0;; ++r) {
        int mt, nt;
        if (!tile_order(r, total, nN, mt, nt)) break;
        if (skip_ctx) mt = (mt >> 4) * 18 + 2 + (mt & 15);
        gemm_tile<EPI>(p, l, A, lda, Bt, K, mt * 128, nt * 128, smem);
    }
}

template <int EPI>
__device__ __forceinline__ void gemm_phase3(const Params& p, int l, const u16* A, int lda, const u16* Bt, int K, int nN, bool skip_ctx, unsigned char* smem) {
    const int nM = skip_ctx ? 176 : 192;
    const int total = nM * nN;
    for (int r = 0;; ++r) {
        int mt, nt;
        if (!tile_order(r, total, nN, mt, nt)) break;
        if (skip_ctx) { const int bb = mt / 11; mt = bb * 12 + 1 + (mt - bb * 11); }
        gemm_tile3<EPI>(p, l, A, lda, Bt, K, mt * 192, nt * 128, smem);
    }
}

typedef __attribute__((address_space(3))) unsigned char lds_byte_t;
template <int OFF> __device__ __forceinline__ void dsr128(bf16x8& d, unsigned addr) { asm volatile("ds_read_b128 %0, %1 offset:%2" : "=v"(d) : "v"(addr), "n"(OFF)); }
template <int N> __device__ __forceinline__ void wait_lgkm_frag(bf16x8& r) { asm volatile("s_waitcnt lgkmcnt(%1)" : "+v"(r) : "n"(N)); }
template <int NI, int NQB, int KC, int I>
__device__ __forceinline__ void pv_frags(bf16x8 (&vb)[3], unsigned va, const bf16x8 (&pf)[NQB], f32x4 (&o)[NQB][NI]) {
    if constexpr (I + 2 < NI) dsr128<((I + 2) * 2 + KC) * 1024>(vb[(I + 2) % 3], va);
    wait_lgkm_frag<((NI - 1 - I) < 2 ? (NI - 1 - I) : 2)>(vb[I % 3]);
    __builtin_amdgcn_sched_barrier(0);
#pragma unroll
    for (int qb = 0; qb < NQB; ++qb) o[qb][I] = __builtin_amdgcn_mfma_f32_16x16x32_bf16(vb[I % 3], pf[qb], o[qb][I], 0, 0, 0);
    __builtin_amdgcn_sched_barrier(0);
    if constexpr (I + 1 < NI) pv_frags<NI, NQB, KC, I + 1>(vb, va, pf, o);
}
template <int NI, int NQB, int KC>
__device__ __forceinline__ void pv_chunk(unsigned va, const bf16x8 (&pf)[NQB], f32x4 (&o)[NQB][NI]) {
    bf16x8 vb[3];
    __builtin_amdgcn_sched_barrier(0);
    dsr128<(0 * 2 + KC) * 1024>(vb[0], va);
    dsr128<(1 * 2 + KC) * 1024>(vb[1], va);
    pv_frags<NI, NQB, KC, 0>(vb, va, pf, o);
}
template <int NDS, int NQB, int F>
__device__ __forceinline__ void s_frags(bf16x8 (&kb)[3], unsigned ka, const bf16x8 (&qf)[NQB][NDS], f32x4 (&s)[4][NQB]) {
    constexpr int NF = 4 * NDS;
    if constexpr (F + 2 < NF) dsr128<(((F + 2) % 4) * NDS + (F + 2) / 4) * 1024>(kb[(F + 2) % 3], ka);
    wait_lgkm_frag<((NF - 1 - F) < 2 ? (NF - 1 - F) : 2)>(kb[F % 3]);
    __builtin_amdgcn_sched_barrier(0);
#pragma unroll
    for (int qb = 0; qb < NQB; ++qb) s[F % 4][qb] = __builtin_amdgcn_mfma_f32_16x16x32_bf16(kb[F % 3], qf[qb][F / 4], s[F % 4][qb], 0, 0, 0);
    __builtin_amdgcn_sched_barrier(0);
    if constexpr (F + 1 < NF) s_frags<NDS, NQB, F + 1>(kb, ka, qf, s);
}
template <int NDS, int NQB, int KC, int F>
__device__ __forceinline__ void sh_frags(bf16x8 (&kb)[3], unsigned ka, const bf16x8 (&qf)[NQB][NDS], f32x4 (&s)[2][NQB]) {
    constexpr int NF = 2 * NDS;
    if constexpr (F + 2 < NF) dsr128<((2 * KC + (F + 2) % 2) * NDS + (F + 2) / 2) * 1024>(kb[(F + 2) % 3], ka);
    wait_lgkm_frag<((NF - 1 - F) < 2 ? (NF - 1 - F) : 2)>(kb[F % 3]);
    __builtin_amdgcn_sched_barrier(0);
#pragma unroll
    for (int qb = 0; qb < NQB; ++qb) s[F % 2][qb] = __builtin_amdgcn_mfma_f32_16x16x32_bf16(kb[F % 3], qf[qb][F / 2], s[F % 2][qb], 0, 0, 0);
    __builtin_amdgcn_sched_barrier(0);
    if constexpr (F + 1 < NF) sh_frags<NDS, NQB, KC, F + 1>(kb, ka, qf, s);
}
template <int NDS, int NQB, int KC>
__device__ __forceinline__ void sh_chunk(unsigned ka, const bf16x8 (&qf)[NQB][NDS], f32x4 (&s)[2][NQB]) {
    bf16x8 kb[3];
    __builtin_amdgcn_sched_barrier(0);
    dsr128<((2 * KC + 0) * NDS + 0) * 1024>(kb[0], ka);
    dsr128<((2 * KC + 1) * NDS + 0) * 1024>(kb[1], ka);
    sh_frags<NDS, NQB, KC, 0>(kb, ka, qf, s);
}
template <int N> __device__ __forceinline__ void wait_vm() { asm volatile("s_waitcnt vmcnt(%0)" :: "n"(N) : "memory"); }

template <int DQK, int DV, int NQB, int MODE, bool HALF = false>
__device__ __forceinline__ void attn_pass(const u16* __restrict__ Qw, int ldq, const u16* __restrict__ Kb, const u16* __restrict__ Vtb,
                                          int ra0, int ra1, int rb0, int rb1, float scale_log2, float sink_log2, int qpos0,
                                          unsigned char* smem, f32x4 (&o)[NQB][DV / 16]) {
    constexpr int NDS = DQK / 32, NI = DV / 16;
    constexpr int KBYTES = 4 * NDS * 1024, VBYTES = NI * 2 * 1024, STG = KBYTES + VBYTES;
    constexpr int NST = (LDS_BYTES / STG) > 4 ? 4 : (LDS_BYTES / STG);
    constexpr int KPW = NDS, VPW = NI / 2, IPT = KPW + VPW;
    static_assert(NST >= 3, "ring too shallow");
    const int tid = opaque_tid(), lane = tid & 63, wid = tid >> 6, fr = lane & 15, fq = lane >> 4;
    bf16x8 qf[NQB][DQK / 32];
#pragma unroll
    for (int qb = 0; qb < NQB; ++qb)
#pragma unroll
        for (int ks = 0; ks < DQK / 32; ++ks) qf[qb][ks] = *(const bf16x8*)(Qw + (size_t)(qb * 16 + fr) * ldq + ks * 32 + fq * 8);
    float m[NQB];
    f32x4 lacc[NQB];
    const bf16x8 ones = {(short)0x3F80, (short)0x3F80, (short)0x3F80, (short)0x3F80, (short)0x3F80, (short)0x3F80, (short)0x3F80, (short)0x3F80};
#pragma unroll
    for (int qb = 0; qb < NQB; ++qb) {
        m[qb] = (MODE == 1) ? sink_log2 : -INFINITY;
        { const float l0 = (MODE == 1) ? 1.f : 0.f; lacc[qb] = (f32x4){l0, l0, l0, l0}; }
#pragma unroll
        for (int i = 0; i < DV / 16; ++i) o[qb][i] = (f32x4){0.f, 0.f, 0.f, 0.f};
    }
    const int nA = ra1 - ra0, ntiles = nA + (rb1 - rb0);
    const unsigned voff = (unsigned)(lane * 16);
    const unsigned char* Kbase = (const unsigned char*)Kb;
    const unsigned char* Vbase = (const unsigned char*)Vtb;
#define A_ISSUE(kt_, st_) do { unsigned char* sb_ = smem + (st_) * STG; \
        const unsigned char* kp_ = Kbase + (size_t)(kt_) * KBYTES + voff; const unsigned char* vp_ = Vbase + (size_t)(kt_) * VBYTES + voff; \
        _Pragma("unroll") for (int kb_ = 0; kb_ < 4 * NDS; ++kb_) GLDS16(kp_ + kb_ * 1024, sb_ + kb_ * 1024); \
        _Pragma("unroll") for (int vb_ = 0; vb_ < 2 * NI; ++vb_) GLDS16(vp_ + vb_ * 1024, sb_ + KBYTES + vb_ * 1024); } while (0)
#define A_TILE(it_) (((it_) < nA) ? (ra0 + (it_)) : (rb0 + (it_) - nA))
    if (wid < NST - 1 && wid < ntiles) A_ISSUE(A_TILE(wid), wid);
    if (wid == 0) wait_vm<0>();
    __builtin_amdgcn_s_barrier();
    asm volatile("" ::: "memory");
    int st = 0, stn = NST - 1;
    for (int it = 0; it < ntiles; ++it) {
        const int kt = A_TILE(it);
        if (((it + 1) & 3) == wid && it + 1 < ntiles) wait_vm<0>();
        __builtin_amdgcn_s_barrier();
        asm volatile("" ::: "memory");
        if (((it + NST - 1) & 3) == wid && it + NST - 1 < ntiles) { A_ISSUE(A_TILE(it + NST - 1), stn); }
        const unsigned char* Ks = smem + st * STG + fr * 64 + fq * 16;
        const unsigned char* Vs = Ks + KBYTES;
        if constexpr (HALF) {
            const unsigned ka = (unsigned)(uintptr_t)(lds_byte_t*)Ks;
            const unsigned va = (unsigned)(uintptr_t)(lds_byte_t*)Vs;
#pragma unroll
            for (int kc = 0; kc < 2; ++kc) {
                f32x4 s[2][NQB];
#pragma unroll
                for (int kl = 0; kl < 2; ++kl)
#pragma unroll
                    for (int qb = 0; qb < NQB; ++qb) s[kl][qb] = (f32x4){0.f, 0.f, 0.f, 0.f};
                if (kc == 0) sh_chunk<NDS, NQB, 0>(ka, qf, s); else sh_chunk<NDS, NQB, 1>(ka, qf, s);
                float mxl[NQB];
                bool need = false;
#pragma unroll
                for (int qb = 0; qb < NQB; ++qb) {
                    float mx = -INFINITY;
#pragma unroll
                    for (int kl = 0; kl < 2; ++kl)
#pragma unroll
                        for (int j = 0; j < 4; ++j) {
                            float v = s[kl][qb][j];
                            if (MODE == 1) {
                                if (kt >= 4) {
                                    const int d = (qpos0 + qb * 16 + fr) - ((kt - 4) * 64 + 32 * kc + fq * 8 + kl * 4 + j);
                                    if (d > 128 || d < -128) v = -1e30f;
                                }
                                s[kl][qb][j] = v;
                            }
                            mx = fmaxf(mx, v);
                        }
                    mxl[qb] = mx;
                    need = need || (mx * scale_log2 > m[qb] + 8.f);
                }
                if (__any(need)) {
#pragma unroll
                    for (int qb = 0; qb < NQB; ++qb) {
                        float mx = mxl[qb];
                        mx = fmaxf(mx, __shfl_xor(mx, 16));
                        mx = fmaxf(mx, __shfl_xor(mx, 32));
                        const float mnew = fmaxf(m[qb], mx * scale_log2);
                        const float alpha = __builtin_amdgcn_exp2f(m[qb] - mnew);
                        m[qb] = mnew;
                        lacc[qb] = lacc[qb] * alpha;
#pragma unroll
                        for (int i = 0; i < DV / 16; ++i) o[qb][i] = o[qb][i] * alpha;
                    }
                }
                bf16x8 pf[NQB];
#pragma unroll
                for (int qb = 0; qb < NQB; ++qb) {
                    const float mq = m[qb];
                    float e[2][4];
#pragma unroll
                    for (int kl = 0; kl < 2; ++kl)
#pragma unroll
                        for (int j = 0; j < 4; ++j) e[kl][j] = __builtin_amdgcn_exp2f(__builtin_fmaf(s[kl][qb][j], scale_log2, -mq));
                    u32x4 cu;
                    cu[0] = pk2(e[0][0], e[0][1]); cu[1] = pk2(e[0][2], e[0][3]); cu[2] = pk2(e[1][0], e[1][1]); cu[3] = pk2(e[1][2], e[1][3]);
                    pf[qb] = __builtin_bit_cast(bf16x8, cu);
                    lacc[qb] = __builtin_amdgcn_mfma_f32_16x16x32_bf16(ones, pf[qb], lacc[qb], 0, 0, 0);
                }
                if (kc == 0) pv_chunk<DV / 16, NQB, 0>(va, pf, o); else pv_chunk<DV / 16, NQB, 1>(va, pf, o);
            }
        } else {
        f32x4 s[4][NQB];
#pragma unroll
        for (int kk = 0; kk < 4; ++kk)
#pragma unroll
            for (int qb = 0; qb < NQB; ++qb) s[kk][qb] = (f32x4){0.f, 0.f, 0.f, 0.f};
        {
            const unsigned ka = (unsigned)(uintptr_t)(lds_byte_t*)Ks;
            bf16x8 kb[3];
            __builtin_amdgcn_sched_barrier(0);
            dsr128<(0 * NDS + 0) * 1024>(kb[0], ka);
            dsr128<(1 * NDS + 0) * 1024>(kb[1], ka);
            s_frags<NDS, NQB, 0>(kb, ka, qf, s);
        }
        float mxl[NQB];
        bool need = false;
#pragma unroll
        for (int qb = 0; qb < NQB; ++qb) {
            float mx = -INFINITY;
#pragma unroll
            for (int kk = 0; kk < 4; ++kk)
#pragma unroll
                for (int j = 0; j < 4; ++j) {
                    float v = s[kk][qb][j];
                    if (MODE == 1) {
                        if (kt >= 4) {
                            const int d = (qpos0 + qb * 16 + fr) - ((kt - 4) * 64 + 32 * (kk >> 1) + fq * 8 + (kk & 1) * 4 + j);
                            if (d > 128 || d < -128) v = -1e30f;
                        }
                        s[kk][qb][j] = v;
                    }
                    mx = fmaxf(mx, v);
                }
            mxl[qb] = mx;
            need = need || (mx * scale_log2 > m[qb] + 8.f);
        }
        if (__any(need)) {
#pragma unroll
            for (int qb = 0; qb < NQB; ++qb) {
                float mx = mxl[qb];
                mx = fmaxf(mx, __shfl_xor(mx, 16));
                mx = fmaxf(mx, __shfl_xor(mx, 32));
                const float mnew = fmaxf(m[qb], mx * scale_log2);
                const float alpha = __builtin_amdgcn_exp2f(m[qb] - mnew);
                m[qb] = mnew;
                lacc[qb] = lacc[qb] * alpha;
#pragma unroll
                for (int i = 0; i < DV / 16; ++i) o[qb][i] = o[qb][i] * alpha;
            }
        }
#pragma unroll
        for (int qb = 0; qb < NQB; ++qb) {
            const float mq = m[qb];
#pragma unroll
            for (int kk = 0; kk < 4; ++kk)
#pragma unroll
                for (int j = 0; j < 4; ++j) s[kk][qb][j] = __builtin_amdgcn_exp2f(__builtin_fmaf(s[kk][qb][j], scale_log2, -mq));
        }
#pragma unroll
        for (int kc = 0; kc < 2; ++kc) {
            bf16x8 pf[NQB];
#pragma unroll
            for (int qb = 0; qb < NQB; ++qb) {
                u32x4 cu;
                cu[0] = pk2(s[2 * kc][qb][0], s[2 * kc][qb][1]); cu[1] = pk2(s[2 * kc][qb][2], s[2 * kc][qb][3]);
                cu[2] = pk2(s[2 * kc + 1][qb][0], s[2 * kc + 1][qb][1]); cu[3] = pk2(s[2 * kc + 1][qb][2], s[2 * kc + 1][qb][3]);
                pf[qb] = __builtin_bit_cast(bf16x8, cu);
                lacc[qb] = __builtin_amdgcn_mfma_f32_16x16x32_bf16(ones, pf[qb], lacc[qb], 0, 0, 0);
            }
            const unsigned va = (unsigned)(uintptr_t)(lds_byte_t*)Vs;
            if (kc == 0) pv_chunk<DV / 16, NQB, 0>(va, pf, o); else pv_chunk<DV / 16, NQB, 1>(va, pf, o);
        }
        }
        st = (st + 1 == NST) ? 0 : st + 1;
        stn = (stn + 1 == NST) ? 0 : stn + 1;
    }
#pragma unroll
    for (int qb = 0; qb < NQB; ++qb) {
        const float inv = 1.f / lacc[qb][0];
#pragma unroll
        for (int i = 0; i < DV / 16; ++i) o[qb][i] = o[qb][i] * inv;
    }
    __syncthreads();
}

template <int NQB, int NI>
__device__ __forceinline__ void store_o(u16* O, int row0, int col0, const f32x4 (&o)[NQB][NI]) {
    const int lane = opaque_tid() & 63, fr = lane & 15, fq = lane >> 4;
#pragma unroll
    for (int qb = 0; qb < NQB; ++qb)
#pragma unroll
        for (int i = 0; i < NI; ++i) {
            uint2 w; w.x = pk2(o[qb][i][0], o[qb][i][1]); w.y = pk2(o[qb][i][2], o[qb][i][3]);
            *(uint2*)(O + tiled_off(row0 + qb * 16 + fr, col0 + i * 16 + fq * 4, DM)) = w;
        }
}

__device__ __forceinline__ void attn_even_phase(const Params& p, int l, unsigned char* smem) {
    const int wid = opaque_tid() >> 6;
    const int e = l >> 1;
    const bool last = (l == 3);
    const int nq = last ? 16 : 18;
    const int nB = NBATCH * 8 * nq;
    unsigned char* ws = p.ws;
    u16* O = (u16*)(ws + OFF_HO);
    (void)nq; (void)nB;
    const int total = last ? 3072 : 3072 + 128 + 256;
    for (int it = blockIdx.x; it < total; it += gridDim.x) {
        bool isB; int qt, h, b;
        if (it < 3072) {
            isB = it < 1024; const int r = isB ? it : it - 1024;
            if (isB) { qt = 1 + (r & 7); h = (r >> 3) & 7; b = r >> 6; } else { qt = 2 + (r & 15); h = (r >> 4) & 7; b = r >> 7; }
        } else {
            const int r2 = it - 3072; isB = r2 < 128; const int r = isB ? r2 : r2 - 128;
            if (isB) { qt = 0; h = r & 7; b = r >> 3; } else { qt = r & 1; h = (r >> 1) & 7; b = r >> 4; }
        }
        if (isB) {
            const int row0 = b * TOK + qt * 256 + wid * 64;
            f32x4 o[4][4];
            const u16* Q = (const u16*)(ws + P_QB) + (size_t)row0 * 768 + h * 96;
            const u16* Kb = (const u16*)(ws + P_KB) + ((size_t)(b * 8 + h) * TOK) * 96;
            const u16* Vt = (const u16*)(ws + P_VBT) + ((size_t)(b * 8 + h) * 64) * TOK;
            attn_pass<96, 64, 4, 0, true>(Q, 768, Kb, Vt, 0, (qt < 1) ? 4 : 36, 0, 0, 0.10206207261596577f * LOG2E, 0.f, 0, smem, o);
            store_o<4, 4>(O, row0, 512 + h * 64, o);
        } else {
            const int row0 = b * TOK + qt * 128 + wid * 32;
            f32x4 o[2][4];
            const int kvh = h >> 2;
            const u16* Q = (const u16*)(ws + P_QA) + (size_t)row0 * 512 + h * 64;
            const u16* Kb = (const u16*)(ws + P_KA) + ((size_t)(b * 2 + kvh) * TOK) * 64;
            const u16* Vt = (const u16*)(ws + P_VAT) + ((size_t)(b * 2 + kvh) * 64) * TOK;
            const float sink = p.ev_sink[e * 8 + h] * LOG2E;
            int rb0 = 0, rb1 = 0, qpos0 = 0;
            if (qt >= 2) {
                const int n = qt - 2;
                rb0 = (n == 0) ? 4 : 2 * n + 2;
                rb1 = (2 * n + 8 > 36) ? 36 : 2 * n + 8;
                qpos0 = n * 128 + wid * 32;
            }
            attn_pass<64, 64, 2, 1>(Q, 512, Kb, Vt, 0, 4, rb0, rb1, 0.125f * LOG2E, sink, qpos0, smem, o);
            store_o<2, 4>(O, row0, h * 64, o);
        }
    }
}

__device__ __forceinline__ void attn_odd_phase(const Params& p, int l, unsigned char* smem) {
    const int tid0 = opaque_tid(); const int lane = tid0 & 63, wid = tid0 >> 6, fr = lane & 15, fq = lane >> 4;
    const int oi = l >> 1;
    const bool last = (l == 3);
    const int nqd = last ? 32 : 36, nqc = last ? 16 : 18;
    const int nD = NBATCH * 4 * nqd, nC = NBATCH * 8 * nqc;
    unsigned char* ws = p.ws;
    u16* O = (u16*)(ws + OFF_HO);
    const float lam = ((const float*)(ws + OFF_LAM))[oi];
    const float post = 1.f - lam_init_of(l);
    (void)nD; (void)nC;
    const int total = last ? 2048 : 2048 + 128 + 128;
    for (int it = blockIdx.x; it < total; it += gridDim.x) {
        bool isD; int qx, h, b;
        if (it < 2048) {
            isD = it < 1024; const int r = isD ? it : it - 1024;
            if (isD) { qx = 2 + (r & 15); h = (r >> 4) & 3; b = r >> 6; } else { qx = 1 + (r & 7); h = (r >> 3) & 7; b = r >> 6; }
        } else {
            const int r2 = it - 2048; isD = r2 < 128; const int r = isD ? r2 : r2 - 128;
            if (isD) { qx = r & 1; h = (r >> 1) & 3; b = r >> 3; } else { qx = 0; h = r & 7; b = r >> 3; }
        }
        if (isD) {
            const int row0 = b * TOK + qx * 128 + wid * 32;
            const int hi = (qx < 2) ? 4 : 36;
            const u16* Vt = (const u16*)(ws + P_VDT) + ((size_t)(b * 4 + h) * 128) * TOK;
            f32x4 o0[2][8], o1[2][8];
            {
                const u16* Q = (const u16*)(ws + P_QD) + (size_t)row0 * 512 + (h * 2) * 64;
                const u16* Kb = (const u16*)(ws + P_KD) + ((size_t)(b * 8 + h * 2) * TOK) * 64;
                attn_pass<64, 128, 2, 0>(Q, 512, Kb, Vt, 0, hi, 0, 0, 0.125f * LOG2E, 0.f, 0, smem, o0);
            }
            {
                const u16* Q = (const u16*)(ws + P_QD) + (size_t)row0 * 512 + (h * 2 + 1) * 64;
                const u16* Kb = (const u16*)(ws + P_KD) + ((size_t)(b * 8 + h * 2 + 1) * TOK) * 64;
                attn_pass<64, 128, 2, 0>(Q, 512, Kb, Vt, 0, hi, 0, 0, 0.125f * LOG2E, 0.f, 0, smem, o1);
            }
            const float* sg = p.od_subln + oi * 128;
#pragma unroll
            for (int qb = 0; qb < 2; ++qb) {
                float ss = 0.f;
#pragma unroll
                for (int i = 0; i < 8; ++i) {
                    o0[qb][i] = o0[qb][i] - o1[qb][i] * lam;
                    ss += o0[qb][i][0] * o0[qb][i][0] + o0[qb][i][1] * o0[qb][i][1] + o0[qb][i][2] * o0[qb][i][2] + o0[qb][i][3] * o0[qb][i][3];
                }
                ss += __shfl_xor(ss, 16);
                ss += __shfl_xor(ss, 32);
                const float rinv = rsqrtf(ss * (1.f / 128.f) + EPS) * post;
#pragma unroll
                for (int i = 0; i < 8; ++i) {
                    const f32x4 g = *(const f32x4*)(sg + i * 16 + fq * 4);
                    o0[qb][i] = o0[qb][i] * rinv * g;
                }
            }
            store_o<2, 8>(O, row0, 512 + h * 128, o0);
        } else {
            const int qt = qx;
            const int row0 = b * TOK + qt * 256 + wid * 64;
            const int kvh = h >> 2;
            const u16* Q = (const u16*)(ws + P_QC) + (size_t)row0 * 512 + h * 64;
            const u16* Kb = (const u16*)(ws + P_KC) + ((size_t)(b * 2 + kvh) * TOK) * 64;
            const u16* Vt = (const u16*)(ws + P_VCT) + ((size_t)(b * 2 + kvh) * 64) * TOK;
            f32x4 o[4][4];
            attn_pass<64, 64, 4, 0>(Q, 512, Kb, Vt, 0, (qt < 1) ? 4 : 36, 0, 0, 0.125f * LOG2E, 0.f, 0, smem, o);
            store_o<4, 4>(O, row0, h * 64, o);
        }
    }
}

#define XB_TMO      128
#define XB_XCNT(j)  (256  + 64 * (j))
#define XB_XSUB(j)  (1280 + 64 * (j))
#define XB_XGEN(j)  (2304 + 64 * (j))
#define XB_TOP      3328
#define XB_TOPGEN   3392
#define XCD_BAR_WORDS 3456
#define XB_SPIN_CAP (1u << 20)
#define LAS __attribute__((address_space(3)))
__device__ __forceinline__ unsigned xb_ld(unsigned* p)              { return __hip_atomic_load(p, __ATOMIC_RELAXED, __HIP_MEMORY_SCOPE_AGENT); }
__device__ __forceinline__ unsigned xb_add(unsigned* p, unsigned v) { return __hip_atomic_fetch_add(p, v, __ATOMIC_RELAXED, __HIP_MEMORY_SCOPE_AGENT); }
__device__ __forceinline__ unsigned xb_xcc_id() { return (unsigned)__builtin_amdgcn_s_getreg((3 << 11) | 20) & 0xFu; }
#define XB_SPIN(cond, bar) do { unsigned _sp = 0; while (cond) { __builtin_amdgcn_s_sleep(1); \
    if ((++_sp & 255u) == 0u) { if (xb_ld(&(bar)[XB_TMO])) break; if (_sp > XB_SPIN_CAP) { atomicAdd(&(bar)[XB_TMO], 1u); break; } } } } while (0)
struct XcdBarrier { unsigned* bar; unsigned x; unsigned nloc, nx; };
__device__ __forceinline__ XcdBarrier xcd_barrier_post(unsigned* bar) {
    XcdBarrier b; b.bar = bar; b.x = xb_xcc_id(); b.nloc = 0u; b.nx = 0u;
    if (threadIdx.x == 0) (void)xb_add(&bar[XB_XCNT(b.x)], 1u);
    return b;
}
__device__ __forceinline__ void xcd_barrier_complete(unsigned* bar, unsigned x, unsigned& nloc, unsigned& nx) {
    const unsigned G = gridDim.x * gridDim.y * gridDim.z;
    unsigned sum, cnt, mine, sp = 0u;
    for (;;) {
        sum = 0u; cnt = 0u; mine = 0u;
#pragma unroll
        for (unsigned j = 0; j < 16; ++j) { const unsigned c = xb_ld(&bar[XB_XCNT(j)]); sum += c; cnt += (c > 0u) ? 1u : 0u; mine = (j == x) ? c : mine; }
        if (sum == G) break;
        __builtin_amdgcn_s_sleep(1);
        if ((++sp & 255u) == 0u) { if (xb_ld(&bar[XB_TMO])) break; if (sp > XB_SPIN_CAP) { atomicAdd(&bar[XB_TMO], 1u); break; } }
    }
    nloc = mine > 0u ? mine : 1u; nx = cnt > 0u ? cnt : 1u;
}
__device__ __forceinline__ void xcd_barrier(XcdBarrier& b) {
    asm volatile("s_waitcnt vmcnt(0)" ::: "memory");
    __syncthreads();
    if (threadIdx.x == 0) {
        unsigned* bar = b.bar;
        __builtin_amdgcn_s_waitcnt(0);
        unsigned nloc = b.nloc, nx = b.nx;
        if (nloc == 0u) { xcd_barrier_complete(bar, b.x, nloc, nx); b.nloc = nloc; b.nx = nx; }
        const unsigned old = xb_add(&bar[XB_XSUB(b.x)], 1u);
        const unsigned gen = old / nloc;
        if (old + 1u == (gen + 1u) * nloc) {
            __builtin_amdgcn_fence(__ATOMIC_RELEASE, "agent");
            asm volatile("s_waitcnt vmcnt(0)" ::: "memory");
            const unsigned og = xb_add(&bar[XB_TOP], 1u);
            const unsigned tg = og / nx;
            if (og + 1u == (tg + 1u) * nx) xb_add(&bar[XB_TOPGEN], 1u);
            else XB_SPIN(xb_ld(&bar[XB_TOPGEN]) == tg, bar);
            __builtin_amdgcn_fence(__ATOMIC_ACQUIRE, "agent");
            xb_add(&bar[XB_XGEN(b.x)], 1u);
            asm volatile("s_waitcnt vmcnt(0)" ::: "memory");
        } else {
            XB_SPIN(xb_ld(&bar[XB_XGEN(b.x)]) == gen, bar);
            __builtin_amdgcn_fence(__ATOMIC_ACQUIRE, "agent");
            asm volatile("s_waitcnt vmcnt(0)" ::: "memory");
        }
    }
    __syncthreads();
}

__global__ void __launch_bounds__(256, 2) mega_fwd(Params p) {
    extern __shared__ __attribute__((aligned(16))) unsigned char smem[];
    cg::grid_group grid = cg::this_grid();
    unsigned char* ws = p.ws;
    const u16* Wb = (const u16*)(ws + OFF_W);
    const u16* HO = (const u16*)(ws + OFF_HO);
    unsigned* bar = (unsigned*)(ws + OFF_BAR);
    XcdBarrier xb = xcd_barrier_post(bar);

    for (int rep = 0; rep < REP_P0; ++rep) { if (rep) grid.sync(); phase0(p, smem); }
    grid.sync();
    rownorm_phase(p, 0, 0);
    xcd_barrier(xb);
#pragma unroll 1
    for (int l = 0; l < 4; ++l) {
        const bool last = (l == 3);
        if ((l & 1) == 0) {
            const int e = l >> 1;
            for (int rep = 0; rep < REP_GEMM; ++rep) { if (rep) xcd_barrier(xb); gemm_phase<EPI_EIN>(p, l, HO, DM, Wb + W_EIN + (size_t)e * 1280 * 1024, 1024, 10, false, smem); }
            xcd_barrier(xb);
            {
                const int tq = 288 * 6, tkv = 288 * 8;
                for (int rep = 0; rep < REP_GEMM; ++rep) { if (rep) xcd_barrier(xb);
                for (int r = 0;; ++r) {
                    int mt, nt;
                    if (!tile_order(r, tq, 6, mt, nt)) break;
                    gemm_tile<EPI_UQ>(p, l, (const u16*)(ws + P_CQ), 256, Wb + W_UQ + (size_t)e * 768 * 256, 256, mt * 128, nt * 128, smem);
                }
                for (int r = 0;; ++r) {
                    int mt, nt;
                    if (!tile_order(r, tkv, 8, mt, nt)) break;
                    gemm_tile<EPI_UKV>(p, l, (const u16*)(ws + P_CKV), 128, Wb + W_UKV + (size_t)e * 1024 * 128, 128, mt * 128, nt * 128, smem);
                }
                }
            }
            xcd_barrier(xb);
            for (int rep = 0; rep < REP_ATTN; ++rep) { if (rep) xcd_barrier(xb); attn_even_phase(p, l, smem); }
            xcd_barrier(xb);
            for (int rep = 0; rep < REP_GEMM; ++rep) { if (rep) xcd_barrier(xb); gemm_phase3<EPI_Y>(p, l, HO, DM, Wb + W_EOUT + (size_t)e * 1024 * 1024, 1024, 8, last, smem); }
        } else {
            const int o = l >> 1;
            for (int rep = 0; rep < REP_GEMM; ++rep) { if (rep) xcd_barrier(xb); gemm_phase<EPI_OIN>(p, l, HO, DM, Wb + W_OIN + (size_t)o * 2304 * 1024, 1024, 18, false, smem); }
            xcd_barrier(xb);
            for (int rep = 0; rep < REP_ATTN; ++rep) { if (rep) xcd_barrier(xb); attn_odd_phase(p, l, smem); }
            xcd_barrier(xb);
            for (int rep = 0; rep < REP_GEMM; ++rep) { if (rep) xcd_barrier(xb); gemm_phase3<EPI_Y>(p, l, HO, DM, Wb + W_OOUT + (size_t)o * 1024 * 1024, 1024, 8, last, smem); }
        }
        xcd_barrier(xb);
        rownorm_phase(p, 1, l);
        xcd_barrier(xb);
        for (int rep = 0; rep < REP_GEMM; ++rep) { if (rep) xcd_barrier(xb); gemm_phase3<EPI_FFN1>(p, l, HO, DM, Wb + W_FFN1 + (size_t)l * 5632 * 1024, 1024, 44, last, smem); }
        xcd_barrier(xb);
        for (int rep = 0; rep < REP_GEMM; ++rep) { if (rep) xcd_barrier(xb); gemm_phase3<EPI_Y>(p, l, (const u16*)(ws + OFF_ACT), FFH, Wb + W_FFN2 + (size_t)l * 1024 * 2816, 2816, 8, last, smem); }
        xcd_barrier(xb);
        rownorm_phase(p, 2, l);
        if (!last) xcd_barrier(xb);
    }
}

extern "C" void kernel_launch(void* const* d_in, const int* in_sizes, int n_in, void* d_out, int out_size, void* d_ws, size_t ws_size, hipStream_t stream) {
    static int grid_blocks = 0;
    if (grid_blocks == 0) {
        if (n_in != 21 || ws_size < WS_TOTAL) { fprintf(stderr, "kernel_launch: unexpected n_in %d or ws_size %zu (< %zu)\n", n_in, ws_size, (size_t)WS_TOTAL); grid_blocks = -1; return; }
        int dev = 0, cus = 0, per_cu = 0;
        hipGetDevice(&dev);
        hipDeviceGetAttribute(&cus, hipDeviceAttributeMultiprocessorCount, dev);
        if (hipFuncSetAttribute((const void*)mega_fwd, hipFuncAttributeMaxDynamicSharedMemorySize, LDS_BYTES) != hipSuccess) { fprintf(stderr, "kernel_launch: hipFuncSetAttribute failed\n"); grid_blocks = -1; return; }
        if (hipOccupancyMaxActiveBlocksPerMultiprocessor(&per_cu, (const void*)mega_fwd, 256, LDS_BYTES) != hipSuccess || per_cu < 1) { fprintf(stderr, "kernel_launch: occupancy query failed (%d)\n", per_cu); per_cu = 1; (void)hipGetLastError(); }
        if (per_cu > 2) per_cu = 2;
        grid_blocks = cus * per_cu;
    }
    if (grid_blocks < 0) return;
    Params p{};
    p.x = (const float*)d_in[0]; p.c = (const float*)d_in[1]; p.ctx = (const float*)d_in[2]; p.c_ctx = (const float*)d_in[3];
    p.ada_w = (const float*)d_in[4]; p.ada_b = (const float*)d_in[5]; p.norm_g = (const float*)d_in[6];
    p.ffn_w_in = (const float*)d_in[7]; p.ffn_w_out = (const float*)d_in[8];
    p.ev_w_in = (const float*)d_in[9]; p.ev_sink = (const float*)d_in[10]; p.ev_q_norm = (const float*)d_in[11]; p.ev_w_uq = (const float*)d_in[12];
    p.ev_kv_norm = (const float*)d_in[13]; p.ev_w_ukv = (const float*)d_in[14]; p.ev_w_out = (const float*)d_in[15];
    p.od_w_in = (const float*)d_in[16]; p.od_qk_norm = (const float*)d_in[17]; p.od_lambda = (const float*)d_in[18]; p.od_subln = (const float*)d_in[19]; p.od_w_out = (const float*)d_in[20];
    p.out = (float*)d_out; p.ws = (unsigned char*)d_ws;
    if (hipMemsetAsync((unsigned char*)d_ws + OFF_BAR, 0, 16384, stream) != hipSuccess) { fprintf(stderr, "kernel_launch: memset of barrier words failed\n"); return; }
    void* args[] = {&p};
    hipError_t e = hipLaunchCooperativeKernel((const void*)mega_fwd, dim3(grid_blocks), dim3(256), args, LDS_BYTES, stream);
    if (e != hipSuccess) fprintf(stderr, "cooperative launch failed: %s (grid %d)\n", hipGetErrorString(e), grid_blocks);
}
```

```cpp
#include <hip/hip_runtime.h>
#include <hip/hip_cooperative_groups.h>
#include <cstdio>
#include <cstdint>
namespace cg = cooperative_groups;
#ifndef REP_GEMM
#define REP_GEMM 1
#endif
#ifndef REP_ATTN
#define REP_ATTN 1
#endif
#ifndef REP_P0
#define REP_P0 1
#endif

typedef unsigned short u16;
typedef short bf16x8 __attribute__((ext_vector_type(8)));
typedef short bf16x4 __attribute__((ext_vector_type(4)));
typedef float f32x4 __attribute__((ext_vector_type(4)));
typedef unsigned u32x4 __attribute__((ext_vector_type(4)));
typedef unsigned u32x2 __attribute__((ext_vector_type(2)));

constexpr int DM = 1024, NBATCH = 16, SEQ = 2048, CTX = 256, TOK = 2304, MR = NBATCH * TOK, FFH = 2816;
constexpr float EPS = 1e-6f;
constexpr float LOG2E = 1.4426950408889634f;
constexpr int LDS_BYTES = 81920;

constexpr size_t al256(size_t x) { return (x + 255) & ~size_t(255); }
constexpr size_t OFF_MOD = 0;
constexpr size_t OFF_R16 = OFF_MOD + al256(4ull * 17 * 6144 * 4);
constexpr size_t OFF_R8 = OFF_R16 + 8192;
constexpr size_t OFF_LAM = OFF_R8 + 4096;
constexpr size_t OFF_XC = OFF_LAM + 256;
constexpr size_t OFF_W = OFF_XC + (size_t)NBATCH * CTX * DM * 4;
constexpr size_t W_FFN1 = 0;
constexpr size_t W_FFN2 = W_FFN1 + 4ull * 5632 * 1024;
constexpr size_t W_EIN = W_FFN2 + 4ull * 1024 * 2816;
constexpr size_t W_UQ = W_EIN + 2ull * 1280 * 1024;
constexpr size_t W_UKV = W_UQ + 2ull * 768 * 256;
constexpr size_t W_EOUT = W_UKV + 2ull * 1024 * 128;
constexpr size_t W_OIN = W_EOUT + 2ull * 1024 * 1024;
constexpr size_t W_OOUT = W_OIN + 2ull * 2304 * 1024;
constexpr size_t W_END = W_OOUT + 2ull * 1024 * 1024;
constexpr size_t OFF_HO = OFF_W + al256(W_END * 2);
constexpr size_t OFF_R1 = OFF_HO + (size_t)MR * DM * 2;
constexpr size_t OFF_ACT = OFF_R1;
constexpr size_t OFF_Y = OFF_ACT + (size_t)MR * FFH * 2;
constexpr size_t WS_END = OFF_Y + (size_t)MR * DM * 2;
constexpr size_t P_QA = OFF_R1;
constexpr size_t P_KA = P_QA + (size_t)MR * 512 * 2;
constexpr size_t P_VAT = P_KA + (size_t)MR * 128 * 2;
constexpr size_t P_CQ = P_VAT + (size_t)MR * 128 * 2;
constexpr size_t P_CKV = P_CQ + (size_t)MR * 256 * 2;
constexpr size_t P_KPE = P_CKV + (size_t)MR * 128 * 2;
constexpr size_t P_SS = P_KPE + (size_t)MR * 32 * 2;
constexpr size_t P_QB = P_SS + (size_t)MR * 8 * 4;
constexpr size_t P_KB = P_QB + (size_t)MR * 768 * 2;
constexpr size_t P_VBT = P_KB + (size_t)MR * 768 * 2;
constexpr size_t P_EEND = P_VBT + (size_t)MR * 512 * 2;
constexpr size_t P_QC = OFF_R1;
constexpr size_t P_KC = P_QC + (size_t)MR * 512 * 2;
constexpr size_t P_VCT = P_KC + (size_t)MR * 128 * 2;
constexpr size_t P_QD = P_VCT + (size_t)MR * 128 * 2;
constexpr size_t P_KD = P_QD + (size_t)MR * 512 * 2;
constexpr size_t P_VDT = P_KD + (size_t)MR * 512 * 2;
constexpr size_t P_OEND = P_VDT + (size_t)MR * 512 * 2;
static_assert(P_EEND <= WS_END && P_OEND <= WS_END, "projection overlay too large");
constexpr size_t OFF_BAR = WS_END;
constexpr size_t WS_TOTAL = WS_END + 16384;
static_assert(WS_TOTAL <= 536870912ull, "workspace too large");

struct Params {
    const float *x, *c, *ctx, *c_ctx, *ada_w, *ada_b, *norm_g, *ffn_w_in, *ffn_w_out;
    const float *ev_w_in, *ev_sink, *ev_q_norm, *ev_w_uq, *ev_kv_norm, *ev_w_ukv, *ev_w_out;
    const float *od_w_in, *od_qk_norm, *od_lambda, *od_subln, *od_w_out;
    float* out;
    unsigned char* ws;
};

typedef float f32x2_t __attribute__((ext_vector_type(2)));
typedef __bf16 bf16x2_t __attribute__((ext_vector_type(2)));
__device__ __forceinline__ unsigned pk2(float lo, float hi) {
    const f32x2_t v = {lo, hi};
    return __builtin_bit_cast(unsigned, __builtin_convertvector(v, bf16x2_t));
}
__device__ __forceinline__ int opaque_tid() { int t = threadIdx.x; asm volatile("" : "+v"(t)); return t; }
__device__ __forceinline__ u16 f2bf(float f) { return (u16)(pk2(f, 0.f) & 0xffffu); }
__device__ __forceinline__ float bf2f(unsigned h) { return __uint_as_float(h << 16); }
__device__ __forceinline__ float wave_sum(float v) {
#pragma unroll
    for (int o = 1; o < 64; o <<= 1) v += __shfl_xor(v, o);
    return v;
}
__device__ __forceinline__ size_t tiled_off(int row, int k, int K) { return ((size_t)(row >> 4) * (K >> 5) + (k >> 5)) * 512 + (row & 15) * 32 + (k & 31); }
__device__ __forceinline__ size_t ktile_off(int t, int d, int NDS) {
    const int p = t & 63, kk = ((p >> 5) << 1) | ((p >> 2) & 1), r = ((p >> 3) & 3) * 4 + (p & 3);
    return ((size_t)(t >> 6) * (4 * NDS) + kk * NDS + (d >> 5)) * 512 + r * 32 + (d & 31);
}
__device__ __forceinline__ size_t vtile_off(int dv, int t, int NI) {
    return ((size_t)(t >> 6) * (2 * NI) + (dv >> 4) * 2 + ((t >> 5) & 1)) * 512 + (dv & 15) * 32 + (t & 31);
}
__device__ __forceinline__ float lam_init_of(int l) { return 0.8f - 0.6f * expf(-0.3f * (float)l); }

__device__ __forceinline__ void ada_item(const Params& p, int it, unsigned char* smem) {
    const int tid = opaque_tid(), lane = tid & 63, wid = tid >> 6;
    const int l = it / 96, n0 = (it % 96) * 64;
    float* S = (float*)smem;
    for (int i = tid; i < 17 * 1024; i += 256) {
        const int r = i >> 10, k = i & 1023;
        const float cv = (r < 16) ? p.c[r * 1024 + k] : p.c_ctx[k];
        S[i] = cv / (1.f + expf(-cv));
    }
    __syncthreads();
    float acc[17];
#pragma unroll
    for (int r = 0; r < 17; ++r) acc[r] = 0.f;
    const float* W = p.ada_w + (size_t)l * 1024 * 6144 + n0 + lane;
    const int kb = wid * 256;
#pragma unroll 2
    for (int k = kb; k < kb + 256; k += 4) {
        const float w0 = __builtin_nontemporal_load(W + (size_t)k * 6144), w1 = __builtin_nontemporal_load(W + (size_t)(k + 1) * 6144), w2 = __builtin_nontemporal_load(W + (size_t)(k + 2) * 6144), w3 = __builtin_nontemporal_load(W + (size_t)(k + 3) * 6144);
#pragma unroll
        for (int r = 0; r < 17; ++r) {
            const f32x4 s = *(const f32x4*)&S[r * 1024 + k];
            acc[r] += s[0] * w0 + s[1] * w1 + s[2] * w2 + s[3] * w3;
        }
    }
    __syncthreads();
    float* R = (float*)smem;
#pragma unroll
    for (int r = 0; r < 17; ++r) R[(wid * 17 + r) * 64 + lane] = acc[r];
    __syncthreads();
    float* MOD = (float*)(p.ws + OFF_MOD);
    for (int i = tid; i < 17 * 64; i += 256) {
        const int r = i >> 6, n = i & 63;
        const float v = R[(0 * 17 + r) * 64 + n] + R[(1 * 17 + r) * 64 + n] + R[(2 * 17 + r) * 64 + n] + R[(3 * 17 + r) * 64 + n] + p.ada_b[l * 6144 + n0 + n];
        MOD[((size_t)l * 17 + r) * 6144 + n0 + n] = v;
    }
    __syncthreads();
}

__device__ __forceinline__ void wt_tile(const float* __restrict__ src, u16* __restrict__ dst, const float* __restrict__ ksc, int K, int N, int Npad, int mode, int t, unsigned char* smem) {
    const int tid = opaque_tid();
    const int nT = Npad >> 8;
    const int nt = t % nT, kt = t / nT, n0 = nt * 256, k0 = kt * 64;
    float* T = (float*)smem;
    {
        const int c4 = (tid & 63) * 4, ks = tid >> 6, n = n0 + c4;
#pragma unroll
        for (int i = 0; i < 16; ++i) {
            const int k = i * 4 + ks;
            f32x4 v = (n < N) ? __builtin_nontemporal_load((const f32x4*)(src + (size_t)(k0 + k) * N + n)) : (f32x4){0.f, 0.f, 0.f, 0.f};
            if (ksc) v = v * ksc[k0 + k];
            *(f32x4*)(T + k * 260 + c4) = v;
        }
    }
    __syncthreads();
#pragma unroll
    for (int kq = 0; kq < 4; ++kq) {
        const float* s = T + (kq * 16) * 260 + tid;
        uint4 o0, o1;
        o0.x = pk2(s[0 * 260], s[1 * 260]); o0.y = pk2(s[2 * 260], s[3 * 260]); o0.z = pk2(s[4 * 260], s[5 * 260]); o0.w = pk2(s[6 * 260], s[7 * 260]);
        o1.x = pk2(s[8 * 260], s[9 * 260]); o1.y = pk2(s[10 * 260], s[11 * 260]); o1.z = pk2(s[12 * 260], s[13 * 260]); o1.w = pk2(s[14 * 260], s[15 * 260]);
        int nd = n0 + tid;
        if (mode == 1) nd = (nd < FFH) ? ((nd >> 4) * 32 + (nd & 15)) : ((((nd - FFH) >> 4) * 32) + 16 + ((nd - FFH) & 15));
        *(uint4*)(dst + tiled_off(nd, k0 + kq * 16, K)) = o0;
        *(uint4*)(dst + tiled_off(nd, k0 + kq * 16 + 8, K)) = o1;
    }
    __syncthreads();
}

constexpr int T_FFN1 = 16 * 22, T_FFN2 = 44 * 4, T_EIN = 16 * 5, T_UQ = 4 * 3, T_UKV = 2 * 4, T_OUT = 16 * 4, T_OIN = 16 * 9;
constexpr int NT_ALL = 4 * (T_FFN1 + T_FFN2) + 2 * (T_EIN + T_UQ + T_UKV + T_OUT) + 2 * (T_OIN + T_OUT);
constexpr int N_ADA = 4 * 96;

__device__ __forceinline__ void wt_item(const Params& p, int r, unsigned char* smem) {
    u16* Wb = (u16*)(p.ws + OFF_W);
    if (r < 4 * T_FFN1) { const int l = r / T_FFN1; wt_tile(p.ffn_w_in + (size_t)l * 1024 * 5632, Wb + W_FFN1 + (size_t)l * 5632 * 1024, nullptr, 1024, 5632, 5632, 1, r % T_FFN1, smem); return; }
    r -= 4 * T_FFN1;
    if (r < 4 * T_FFN2) { const int l = r / T_FFN2; wt_tile(p.ffn_w_out + (size_t)l * 2816 * 1024, Wb + W_FFN2 + (size_t)l * 1024 * 2816, nullptr, 2816, 1024, 1024, 0, r % T_FFN2, smem); return; }
    r -= 4 * T_FFN2;
    if (r < 2 * T_EIN) { const int e = r / T_EIN; wt_tile(p.ev_w_in + (size_t)e * 1024 * 1184, Wb + W_EIN + (size_t)e * 1280 * 1024, nullptr, 1024, 1184, 1280, 0, r % T_EIN, smem); return; }
    r -= 2 * T_EIN;
    if (r < 2 * T_UQ) { const int e = r / T_UQ; wt_tile(p.ev_w_uq + (size_t)e * 256 * 768, Wb + W_UQ + (size_t)e * 768 * 256, p.ev_q_norm + e * 256, 256, 768, 768, 0, r % T_UQ, smem); return; }
    r -= 2 * T_UQ;
    if (r < 2 * T_UKV) { const int e = r / T_UKV; wt_tile(p.ev_w_ukv + (size_t)e * 128 * 1024, Wb + W_UKV + (size_t)e * 1024 * 128, p.ev_kv_norm + e * 128, 128, 1024, 1024, 0, r % T_UKV, smem); return; }
    r -= 2 * T_UKV;
    if (r < 2 * T_OUT) { const int e = r / T_OUT; wt_tile(p.ev_w_out + (size_t)e * 1024 * 1024, Wb + W_EOUT + (size_t)e * 1024 * 1024, nullptr, 1024, 1024, 1024, 0, r % T_OUT, smem); return; }
    r -= 2 * T_OUT;
    if (r < 2 * T_OIN) { const int o = r / T_OIN; wt_tile(p.od_w_in + (size_t)o * 1024 * 2304, Wb + W_OIN + (size_t)o * 2304 * 1024, nullptr, 1024, 2304, 2304, 0, r % T_OIN, smem); return; }
    r -= 2 * T_OIN;
    { const int o = r / T_OUT; wt_tile(p.od_w_out + (size_t)o * 1024 * 1024, Wb + W_OOUT + (size_t)o * 1024 * 1024, nullptr, 1024, 1024, 1024, 0, r % T_OUT, smem); }
}

__device__ __forceinline__ void misc_item(const Params& p) {
    const int tid = opaque_tid(), lane = tid & 63, wid = tid >> 6;
    float* R16 = (float*)(p.ws + OFF_R16);
    float* R8 = (float*)(p.ws + OFF_R8);
    for (int i = tid; i < 1024; i += 256) {
        const int pos = i >> 4, fi = i & 15;
        const float f = powf(10000.f, -(float)fi / 16.f), a = (float)pos * f;
        R16[2 * i] = cosf(a); R16[2 * i + 1] = sinf(a);
    }
    for (int i = tid; i < 512; i += 256) {
        const int pos = i >> 3, fi = i & 7;
        const float f = powf(10000.f, -(float)fi / 8.f), a = (float)pos * f;
        R8[2 * i] = cosf(a); R8[2 * i + 1] = sinf(a);
    }
    if (wid < 2) {
        const float* lp = p.od_lambda + wid * 256;
        const float sa = wave_sum(lp[lane] * lp[64 + lane]);
        const float sb = wave_sum(lp[128 + lane] * lp[192 + lane]);
        if (lane == 0) ((float*)(p.ws + OFF_LAM))[wid] = expf(sa) - expf(sb) + lam_init_of(2 * wid + 1);
    }
}

__device__ __forceinline__ void phase0(const Params& p, unsigned char* smem) {
    constexpr int TOTAL = N_ADA + NT_ALL + 1;
    for (int it = blockIdx.x; it < TOTAL; it += gridDim.x) {
        if (it < N_ADA) ada_item(p, it, smem);
        else if (it < N_ADA + NT_ALL) wt_item(p, it - N_ADA, smem);
        else misc_item(p);
    }
}

__device__ __forceinline__ f32x4 bf4_to_f32(u32x2 y) {
    f32x4 r; r[0] = bf2f(y[0] & 0xffffu); r[1] = __uint_as_float(y[0] & 0xffff0000u); r[2] = bf2f(y[1] & 0xffffu); r[3] = __uint_as_float(y[1] & 0xffff0000u);
    return r;
}
__device__ __forceinline__ float dot4(f32x4 a) { return a[0] * a[0] + a[1] * a[1] + a[2] * a[2] + a[3] * a[3]; }
__device__ __forceinline__ void rownorm_phase(const Params& p, int mode, int l) {
    const int tid = opaque_tid(), lane = tid & 63, wid = tid >> 6;
    const float* MOD = (const float*)(p.ws + OFF_MOD);
    float* XC = (float*)(p.ws + OFF_XC);
    u16* H = (u16*)(p.ws + OFF_HO);
    const u16* Y = (const u16*)(p.ws + OFF_Y);
    const bool makeH = !(mode == 2 && l == 3);
    const int lh = (mode == 2) ? l + 1 : l;
    const int hsh = (mode == 1) ? 3 : 0, hsc = (mode == 1) ? 4 : 1, hg = (mode == 1) ? 2 : 0;
    const int ug = (mode == 1) ? 2 : 5, ugam = (mode == 1) ? 1 : 3;
    const int col0 = lane * 4;
    for (int ch = blockIdx.x * 4 + wid; ch < MR / 4; ch += gridDim.x * 4) {
        const int row0 = ch * 4;
        const int b = row0 / TOK, t0 = row0 - b * TOK;
        const bool isctx = t0 < CTX;
        if (l == 3 && mode != 0 && isctx) continue;
        const int mb = isctx ? 16 : b;
        float* xp = isctx ? XC + ((size_t)(b * CTX + t0)) * DM : p.out + ((size_t)(b * SEQ + t0 - CTX)) * DM;
        f32x4 xv[4][4];
        if (mode == 0) {
            const float* src = isctx ? p.ctx + ((size_t)(b * CTX + t0)) * DM : p.x + ((size_t)(b * SEQ + t0 - CTX)) * DM;
#pragma unroll
            for (int r = 0; r < 4; ++r)
#pragma unroll
                for (int c = 0; c < 4; ++c) xv[r][c] = __builtin_nontemporal_load((const f32x4*)(src + (size_t)r * DM + c * 256 + col0));
        } else {
            u32x2 yr[4][4];
#pragma unroll
            for (int r = 0; r < 4; ++r)
#pragma unroll
                for (int c = 0; c < 4; ++c) {
                    xv[r][c] = __builtin_nontemporal_load((const f32x4*)(xp + (size_t)r * DM + c * 256 + col0));
                    yr[r][c] = __builtin_nontemporal_load((const u32x2*)(Y + (size_t)(row0 + r) * DM + c * 256 + col0));
                }
            const float* gate = MOD + ((size_t)l * 17 + mb) * 6144 + ug * 1024;
            const float* gam = p.norm_g + ((size_t)l * 4 + ugam) * DM;
            f32x4 gg[4];
#pragma unroll
            for (int c = 0; c < 4; ++c) gg[c] = *(const f32x4*)(gate + c * 256 + col0) * *(const f32x4*)(gam + c * 256 + col0);
            float ss[4];
#pragma unroll
            for (int r = 0; r < 4; ++r) {
                float s = 0.f;
#pragma unroll
                for (int c = 0; c < 4; ++c) s += dot4(bf4_to_f32(yr[r][c]));
                ss[r] = s;
            }
#pragma unroll
            for (int o = 1; o < 64; o <<= 1) {
#pragma unroll
                for (int r = 0; r < 4; ++r) ss[r] += __shfl_xor(ss[r], o);
            }
#pragma unroll
            for (int r = 0; r < 4; ++r) {
                const float rinv = rsqrtf(ss[r] * (1.f / DM) + EPS);
#pragma unroll
                for (int c = 0; c < 4; ++c) xv[r][c] = xv[r][c] + gg[c] * (bf4_to_f32(yr[r][c]) * rinv);
            }
        }
#pragma unroll
        for (int r = 0; r < 4; ++r)
#pragma unroll
            for (int c = 0; c < 4; ++c) __builtin_nontemporal_store(xv[r][c], (f32x4*)(xp + (size_t)r * DM + c * 256 + col0));
        if (makeH) {
            float ss[4];
#pragma unroll
            for (int r = 0; r < 4; ++r) {
                float s = 0.f;
#pragma unroll
                for (int c = 0; c < 4; ++c) s += dot4(xv[r][c]);
                ss[r] = s;
            }
#pragma unroll
            for (int o = 1; o < 64; o <<= 1) {
#pragma unroll
                for (int r = 0; r < 4; ++r) ss[r] += __shfl_xor(ss[r], o);
            }
            const float* mrow = MOD + ((size_t)lh * 17 + mb) * 6144;
            const float* gam = p.norm_g + ((size_t)lh * 4 + hg) * DM;
#pragma unroll
            for (int c = 0; c < 4; ++c) {
                const int col = c * 256 + col0;
                const f32x4 sh = *(const f32x4*)(mrow + hsh * 1024 + col);
                const f32x4 sc = *(const f32x4*)(mrow + hsc * 1024 + col);
                const f32x4 gs = *(const f32x4*)(gam + col) * (sc + 1.f);
#pragma unroll
                for (int r = 0; r < 4; ++r) {
                    const float rinv = rsqrtf(ss[r] * (1.f / DM) + EPS);
                    const f32x4 hv = (xv[r][c] * rinv) * gs + sh;
                    u32x2 o; o[0] = pk2(hv[0], hv[1]); o[1] = pk2(hv[2], hv[3]);
                    *(u32x2*)(H + tiled_off(row0 + r, col, DM)) = o;
                }
            }
        }
    }
}

enum { EPI_EIN = 0, EPI_UQ = 1, EPI_UKV = 2, EPI_OIN = 3, EPI_Y = 4, EPI_FFN1 = 5 };

__device__ __forceinline__ void rope64(float (&v)[64], const float* R16, int t) {
    if (t < CTX) return;
    const int pp = t - CTX, pr = pp >> 6, pc = pp & 63;
    const float2* tr = (const float2*)R16 + pr * 16;
    const float2* tc = (const float2*)R16 + pc * 16;
#pragma unroll
    for (int i = 0; i < 16; ++i) {
        const float2 cs = tr[i];
        const float a = v[i], bb = v[i + 16];
        v[i] = a * cs.x - bb * cs.y; v[i + 16] = bb * cs.x + a * cs.y;
    }
#pragma unroll
    for (int i = 0; i < 16; ++i) {
        const float2 cs = tc[i];
        const float a = v[32 + i], bb = v[48 + i];
        v[32 + i] = a * cs.x - bb * cs.y; v[48 + i] = bb * cs.x + a * cs.y;
    }
}
template <int O>
__device__ __forceinline__ void rope32(float (&v)[64], const float* R8, int t) {
    if (t < CTX) return;
    const int pp = t - CTX, pr = pp >> 6, pc = pp & 63;
    const float2* tr = (const float2*)R8 + pr * 8;
    const float2* tc = (const float2*)R8 + pc * 8;
#pragma unroll
    for (int i = 0; i < 8; ++i) {
        const float2 cs = tr[i];
        const float a = v[O + i], bb = v[O + i + 8];
        v[O + i] = a * cs.x - bb * cs.y; v[O + i + 8] = bb * cs.x + a * cs.y;
    }
#pragma unroll
    for (int i = 0; i < 8; ++i) {
        const float2 cs = tc[i];
        const float a = v[O + 16 + i], bb = v[O + 24 + i];
        v[O + 16 + i] = a * cs.x - bb * cs.y; v[O + 24 + i] = bb * cs.x + a * cs.y;
    }
}
template <int N>
__device__ __forceinline__ void store_row(u16* dst, const float (&v)[64]) {
#pragma unroll
    for (int c = 0; c < N; c += 8) {
        uint4 o; o.x = pk2(v[c], v[c + 1]); o.y = pk2(v[c + 2], v[c + 3]); o.z = pk2(v[c + 4], v[c + 5]); o.w = pk2(v[c + 6], v[c + 7]);
        *(uint4*)(dst + c) = o;
    }
}
__device__ __forceinline__ void store_row_tiled64(u16* base, int row, int k0, int K, const float (&v)[64]) {
#pragma unroll
    for (int c = 0; c < 64; c += 8) {
        uint4 o; o.x = pk2(v[c], v[c + 1]); o.y = pk2(v[c + 2], v[c + 3]); o.z = pk2(v[c + 4], v[c + 5]); o.w = pk2(v[c + 6], v[c + 7]);
        *(uint4*)(base + tiled_off(row, k0 + c, K)) = o;
    }
}
__device__ __forceinline__ void store_k64(u16* head, int t, int d0, int NDS, const float (&v)[64]) {
#pragma unroll
    for (int c = 0; c < 64; c += 8) {
        uint4 o; o.x = pk2(v[c], v[c + 1]); o.y = pk2(v[c + 2], v[c + 3]); o.z = pk2(v[c + 4], v[c + 5]); o.w = pk2(v[c + 6], v[c + 7]);
        *(uint4*)(head + ktile_off(t, d0 + c, NDS)) = o;
    }
}
__device__ __forceinline__ void store_v64(u16* head, int dv0, int t, int NI, const float (&v)[64]) {
#pragma unroll
    for (int c = 0; c < 64; ++c) head[vtile_off(dv0 + c, t, NI)] = f2bf(v[c]);
}
__device__ __forceinline__ void store_T64(u16* dst, const float (&v)[64]) {
#pragma unroll
    for (int c = 0; c < 64; ++c) dst[(size_t)c * TOK] = f2bf(v[c]);
}
__device__ __forceinline__ float sumsq64(const float (&v)[64]) {
    float s = 0.f;
#pragma unroll
    for (int c = 0; c < 64; ++c) s += v[c] * v[c];
    return s;
}

template <int EPI>
__device__ __forceinline__ void epi_seg(const Params& p, int l, int row, int b, int t, int seg, float (&v)[64]) {
    unsigned char* ws = p.ws;
    const float* R16 = (const float*)(ws + OFF_R16);
    const float* R8 = (const float*)(ws + OFF_R8);
    if (EPI == EPI_EIN) {
        if (seg < 8) { rope64(v, R16, t); store_row<64>((u16*)(ws + P_QA) + (size_t)row * 512 + seg * 64, v); }
        else if (seg < 10) { rope64(v, R16, t); store_k64((u16*)(ws + P_KA) + ((size_t)(b * 2 + seg - 8) * TOK) * 64, t, 0, 2, v); }
        else if (seg < 12) { store_v64((u16*)(ws + P_VAT) + ((size_t)(b * 2 + seg - 10) * 64) * TOK, 0, t, 4, v); }
        else if (seg < 16) { ((float*)(ws + P_SS))[(size_t)row * 8 + seg - 12] = sumsq64(v); store_row_tiled64((u16*)(ws + P_CQ), row, (seg - 12) * 64, 256, v); }
        else if (seg < 18) { ((float*)(ws + P_SS))[(size_t)row * 8 + 4 + seg - 16] = sumsq64(v); store_row_tiled64((u16*)(ws + P_CKV), row, (seg - 16) * 64, 128, v); }
        else if (seg == 18) { rope32<0>(v, R8, t); store_row<32>((u16*)(ws + P_KPE) + (size_t)row * 32, v); }
    } else if (EPI == EPI_UQ) {
        const f32x4 s4 = *(const f32x4*)((const float*)(ws + P_SS) + (size_t)row * 8);
        const float rinv = rsqrtf((s4[0] + s4[1] + s4[2] + s4[3]) * (1.f / 256.f) + EPS);
#pragma unroll
        for (int c = 0; c < 64; ++c) v[c] *= rinv;
        if (((2 * seg) % 3) == 2) rope32<0>(v, R8, t);
        if (((2 * seg + 1) % 3) == 2) rope32<32>(v, R8, t);
        store_row<64>((u16*)(ws + P_QB) + (size_t)row * 768 + seg * 64, v);
    } else if (EPI == EPI_UKV) {
        const float* ssp = (const float*)(ws + P_SS) + (size_t)row * 8;
        const float rinv = rsqrtf((ssp[4] + ssp[5]) * (1.f / 128.f) + EPS);
#pragma unroll
        for (int c = 0; c < 64; ++c) v[c] *= rinv;
        const int h = seg >> 1;
        if ((seg & 1) == 0) {
            u16* kh = (u16*)(ws + P_KB) + ((size_t)(b * 8 + h) * TOK) * 96;
            store_k64(kh, t, 0, 3, v);
            const uint4* kp = (const uint4*)((const u16*)(ws + P_KPE) + (size_t)row * 32);
#pragma unroll
            for (int c = 0; c < 4; ++c) *(uint4*)(kh + ktile_off(t, 64 + c * 8, 3)) = kp[c];
        } else {
            store_v64((u16*)(ws + P_VBT) + ((size_t)(b * 8 + h) * 64) * TOK, 0, t, 4, v);
        }
    } else if (EPI == EPI_OIN) {
        const int o = l >> 1;
        if (seg < 10) {
            const float* g = p.od_qk_norm + (size_t)o * 128 + (seg < 8 ? 0 : 64);
            const float rinv = rsqrtf(sumsq64(v) * (1.f / 64.f) + EPS);
#pragma unroll
            for (int c = 0; c < 64; ++c) v[c] = v[c] * rinv * g[c];
            rope64(v, R16, t);
            if (seg < 8) store_row<64>((u16*)(ws + P_QC) + (size_t)row * 512 + seg * 64, v);
            else store_k64((u16*)(ws + P_KC) + ((size_t)(b * 2 + seg - 8) * TOK) * 64, t, 0, 2, v);
        } else if (seg < 12) { store_v64((u16*)(ws + P_VCT) + ((size_t)(b * 2 + seg - 10) * 64) * TOK, 0, t, 4, v); }
        else if (seg < 20) { rope64(v, R16, t); store_row<64>((u16*)(ws + P_QD) + (size_t)row * 512 + (seg - 12) * 64, v); }
        else if (seg < 28) { rope64(v, R16, t); store_k64((u16*)(ws + P_KD) + ((size_t)(b * 8 + seg - 20) * TOK) * 64, t, 0, 2, v); }
        else { const int s2 = seg - 28; store_v64((u16*)(ws + P_VDT) + ((size_t)(b * 4 + (s2 >> 1)) * 128) * TOK, (s2 & 1) * 64, t, 8, v); }
    } else if (EPI == EPI_Y) {
        store_row<64>((u16*)(ws + OFF_Y) + (size_t)row * DM + seg * 64, v);
    }
}

template <int EPI, int ROWS>
__device__ __forceinline__ void epi_process(const Params& p, int l, int m0, int n0, const float* Cs, int tid) {
    if (EPI == EPI_FFN1) {
        const int c8 = (tid & 7) * 8;
        u16* dst = (u16*)(p.ws + OFF_ACT) + (size_t)m0 * FFH + (n0 >> 7) * 64 + c8;
#pragma unroll
        for (int ps = 0; ps < ROWS / 32; ++ps) {
            const int rl = ps * 32 + (tid >> 3);
            const f32x4 g0 = *(const f32x4*)(Cs + rl * 132 + c8), g1 = *(const f32x4*)(Cs + rl * 132 + c8 + 4);
            const f32x4 u0 = *(const f32x4*)(Cs + rl * 132 + 64 + c8), u1 = *(const f32x4*)(Cs + rl * 132 + 64 + c8 + 4);
            float o[8];
#pragma unroll
            for (int c = 0; c < 4; ++c) { o[c] = g0[c] / (1.f + __expf(-g0[c])) * u0[c]; o[4 + c] = g1[c] / (1.f + __expf(-g1[c])) * u1[c]; }
            u32x4 w; w[0] = pk2(o[0], o[1]); w[1] = pk2(o[2], o[3]); w[2] = pk2(o[4], o[5]); w[3] = pk2(o[6], o[7]);
            *(u32x4*)(dst + (size_t)rl * FFH) = w;
        }
    } else if (EPI == EPI_Y) {
        const int c8 = (tid & 15) * 8;
        u16* dst = (u16*)(p.ws + OFF_Y) + (size_t)m0 * DM + n0 + c8;
#pragma unroll
        for (int ps = 0; ps < ROWS / 16; ++ps) {
            const int rl = ps * 16 + (tid >> 4);
            const f32x4 v0 = *(const f32x4*)(Cs + rl * 132 + c8), v1 = *(const f32x4*)(Cs + rl * 132 + c8 + 4);
            u32x4 w; w[0] = pk2(v0[0], v0[1]); w[1] = pk2(v0[2], v0[3]); w[2] = pk2(v1[0], v1[1]); w[3] = pk2(v1[2], v1[3]);
            *(u32x4*)(dst + (size_t)rl * DM) = w;
        }
    } else {
        if (tid < 2 * ROWS) {
            const int sl = tid / ROWS, rl = tid - sl * ROWS;
            const int row = m0 + rl;
            float v[64];
#pragma unroll
            for (int c = 0; c < 64; ++c) v[c] = Cs[rl * 129 + sl * 64 + c];
            const int b = row / TOK, t = row - b * TOK;
            epi_seg<EPI>(p, l, row, b, t, (n0 >> 6) + sl, v);
        }
    }
}

template <int EPI>
__device__ __forceinline__ void gemm_tile(const Params& p, int l, const u16* __restrict__ A, int lda, const u16* __restrict__ Bt, int K, int m0, int n0, unsigned char* smem) {
    const int tid = opaque_tid(), lane = tid & 63, wid = tid >> 6, wr = wid >> 1, wc = wid & 1, fr = lane & 15, fq = lane >> 4;
    f32x4 acc[4][4];
#pragma unroll
    for (int i = 0; i < 4; ++i)
#pragma unroll
        for (int j = 0; j < 4; ++j) acc[i][j] = (f32x4){0.f, 0.f, 0.f, 0.f};
    const unsigned voff = (unsigned)(lane * 16);
    const size_t ksub = (size_t)(K >> 5) * 1024;
    const unsigned char* Abase = (const unsigned char*)A + (size_t)(m0 >> 4) * ksub;
    const unsigned char* Bbase = (const unsigned char*)Bt + (size_t)(n0 >> 4) * ksub;
    (void)lda;
#define GLDS16(gp, lp) __builtin_amdgcn_global_load_lds((const unsigned*)(gp), (unsigned*)(lp), 16, 0, 0)
#define G_TILE(kt_, st_) do { const size_t ko_ = (size_t)(kt_) * 1024; unsigned char* d_ = smem + (st_) * 16384; \
        _Pragma("unroll") for (int s_ = 0; s_ < 8; ++s_) GLDS16(Abase + (size_t)s_ * ksub + ko_ + voff, d_ + s_ * 1024); \
        _Pragma("unroll") for (int s_ = 0; s_ < 8; ++s_) GLDS16(Bbase + (size_t)s_ * ksub + ko_ + voff, d_ + 8192 + s_ * 1024); } while (0)
    const int nk = K >> 5;
    G_TILE(wid, wid);
    const unsigned char* fa = smem + (wr * 4) * 1024 + fr * 64 + fq * 16;
    const unsigned char* fb = smem + 8192 + (wc * 4) * 1024 + fr * 64 + fq * 16;
    int st = 0, stn = 4;
    if (wid == 0) asm volatile("s_waitcnt vmcnt(0)" ::: "memory");
    __builtin_amdgcn_s_barrier();
    asm volatile("" ::: "memory");
    for (int kt = 0; kt < nk; ++kt) {
        if (((kt + 1) & 3) == wid && kt + 1 < nk) asm volatile("s_waitcnt vmcnt(0)" ::: "memory");
        __builtin_amdgcn_s_barrier();
        asm volatile("" ::: "memory");
        if ((kt & 3) == wid && kt + 4 < nk) G_TILE(kt + 4, stn);
        const int so = st * 16384;
        bf16x8 af[4], bv[4];
#pragma unroll
        for (int i = 0; i < 4; ++i) af[i] = *(const bf16x8*)(fa + so + i * 1024);
#pragma unroll
        for (int j = 0; j < 4; ++j) bv[j] = *(const bf16x8*)(fb + so + j * 1024);
        __builtin_amdgcn_s_setprio(1);
#pragma unroll
        for (int i = 0; i < 4; ++i)
#pragma unroll
            for (int j = 0; j < 4; ++j) acc[i][j] = __builtin_amdgcn_mfma_f32_16x16x32_bf16(af[i], bv[j], acc[i][j], 0, 0, 0);
        __builtin_amdgcn_s_setprio(0);
        st = (st == 4) ? 0 : st + 1;
        stn = (stn == 4) ? 0 : stn + 1;
    }
    __syncthreads();
    float* Cs = (float*)smem;
    constexpr int CS = (EPI == EPI_FFN1 || EPI == EPI_Y) ? 132 : 129;
#pragma unroll
    for (int i = 0; i < 4; ++i)
#pragma unroll
        for (int j = 0; j < 4; ++j)
#pragma unroll
            for (int r = 0; r < 4; ++r) Cs[(wr * 64 + i * 16 + fq * 4 + r) * CS + wc * 64 + j * 16 + fr] = acc[i][j][r];
    __syncthreads();
    epi_process<EPI, 128>(p, l, m0, n0, Cs, tid);
    __syncthreads();
}

template <int EPI>
__device__ __forceinline__ void gemm_tile3(const Params& p, int l, const u16* __restrict__ A, int lda, const u16* __restrict__ Bt, int K, int m0, int n0, unsigned char* smem) {
    const int tid = opaque_tid(), lane = tid & 63, wid = tid >> 6, wr = wid >> 1, wc = wid & 1, fr = lane & 15, fq = lane >> 4;
    f32x4 acc[6][4];
#pragma unroll
    for (int i = 0; i < 6; ++i)
#pragma unroll
        for (int j = 0; j < 4; ++j) acc[i][j] = (f32x4){0.f, 0.f, 0.f, 0.f};
    const unsigned voff = (unsigned)(lane * 16);
    const size_t ksub = (size_t)(K >> 5) * 1024;
    const unsigned char* Abase = (const unsigned char*)A + (size_t)(m0 >> 4) * ksub;
    const unsigned char* Bbase = (const unsigned char*)Bt + (size_t)(n0 >> 4) * ksub;
    (void)lda;
#define G3_TILE(kt_, st_) do { const size_t ko_ = (size_t)(kt_) * 1024; unsigned char* d_ = smem + (st_) * 20480; \
        _Pragma("unroll") for (int s_ = 0; s_ < 12; ++s_) GLDS16(Abase + (size_t)s_ * ksub + ko_ + voff, d_ + s_ * 1024); \
        _Pragma("unroll") for (int s_ = 0; s_ < 8; ++s_) GLDS16(Bbase + (size_t)s_ * ksub + ko_ + voff, d_ + 12288 + s_ * 1024); } while (0)
    const int nk = K >> 5;
    if (wid < 3) G3_TILE(wid, wid);
    const unsigned char* fa = smem + (wr * 6) * 1024 + fr * 64 + fq * 16;
    const unsigned char* fb = smem + 12288 + (wc * 4) * 1024 + fr * 64 + fq * 16;
    int st = 0, stn = 3;
    if (wid == 0) asm volatile("s_waitcnt vmcnt(0)" ::: "memory");
    asm volatile("s_waitcnt lgkmcnt(0)" ::: "memory");
    __builtin_amdgcn_s_barrier();
    asm volatile("" ::: "memory");
    for (int kt = 0; kt < nk; ++kt) {
        if (((kt + 1) & 3) == wid && kt + 1 < nk) asm volatile("s_waitcnt vmcnt(0)" ::: "memory");
        __builtin_amdgcn_s_barrier();
        asm volatile("" ::: "memory");
        if (((kt + 3) & 3) == wid && kt + 3 < nk) G3_TILE(kt + 3, stn);
        const int so = st * 20480;
        bf16x8 af[6], bv[4];
        {
            typedef __attribute__((address_space(3))) unsigned char lds_u8;
            const unsigned la = (unsigned)(uintptr_t)(lds_u8*)(fa + so);
            const unsigned lb = (unsigned)(uintptr_t)(lds_u8*)(fb + so);
#define DSR128(dst_, addr_, off_) asm volatile("ds_read_b128 %0, %1 offset:" #off_ : "=v"(dst_) : "v"(addr_))
            DSR128(bv[0], lb, 0); DSR128(bv[1], lb, 1024); DSR128(bv[2], lb, 2048); DSR128(bv[3], lb, 3072);
            DSR128(af[0], la, 0); DSR128(af[1], la, 1024); DSR128(af[2], la, 2048); DSR128(af[3], la, 3072); DSR128(af[4], la, 4096); DSR128(af[5], la, 5120);
        }
        __builtin_amdgcn_sched_barrier(0);
        asm volatile("s_waitcnt lgkmcnt(5)" : "+v"(bv[0]), "+v"(bv[1]), "+v"(bv[2]), "+v"(bv[3]), "+v"(af[0]));
        __builtin_amdgcn_sched_barrier(0);
#pragma unroll
        for (int j = 0; j < 4; ++j) acc[0][j] = __builtin_amdgcn_mfma_f32_16x16x32_bf16(bv[j], af[0], acc[0][j], 0, 0, 0);
        __builtin_amdgcn_sched_barrier(0);
        asm volatile("s_waitcnt lgkmcnt(4)" : "+v"(af[1]));
        __builtin_amdgcn_sched_barrier(0);
#pragma unroll
        for (int j = 0; j < 4; ++j) acc[1][j] = __builtin_amdgcn_mfma_f32_16x16x32_bf16(bv[j], af[1], acc[1][j], 0, 0, 0);
        __builtin_amdgcn_sched_barrier(0);
        asm volatile("s_waitcnt lgkmcnt(3)" : "+v"(af[2]));
        __builtin_amdgcn_sched_barrier(0);
#pragma unroll
        for (int j = 0; j < 4; ++j) acc[2][j] = __builtin_amdgcn_mfma_f32_16x16x32_bf16(bv[j], af[2], acc[2][j], 0, 0, 0);
        __builtin_amdgcn_sched_barrier(0);
        asm volatile("s_waitcnt lgkmcnt(2)" : "+v"(af[3]));
        __builtin_amdgcn_sched_barrier(0);
#pragma unroll
        for (int j = 0; j < 4; ++j) acc[3][j] = __builtin_amdgcn_mfma_f32_16x16x32_bf16(bv[j], af[3], acc[3][j], 0, 0, 0);
        __builtin_amdgcn_sched_barrier(0);
        asm volatile("s_waitcnt lgkmcnt(1)" : "+v"(af[4]));
        __builtin_amdgcn_sched_barrier(0);
#pragma unroll
        for (int j = 0; j < 4; ++j) acc[4][j] = __builtin_amdgcn_mfma_f32_16x16x32_bf16(bv[j], af[4], acc[4][j], 0, 0, 0);
        __builtin_amdgcn_sched_barrier(0);
        asm volatile("s_waitcnt lgkmcnt(0)" : "+v"(af[5]));
        __builtin_amdgcn_sched_barrier(0);
#pragma unroll
        for (int j = 0; j < 4; ++j) acc[5][j] = __builtin_amdgcn_mfma_f32_16x16x32_bf16(bv[j], af[5], acc[5][j], 0, 0, 0);
        st = (st + 1) & 3;
        stn = (stn + 1) & 3;
    }
    __syncthreads();
    static_assert(EPI == EPI_FFN1 || EPI == EPI_Y, "gemm_tile3 has the plain epilogues only");
    const int rowb = m0 + wr * 96 + fr;
    if (EPI == EPI_Y) {
        u16* dst = (u16*)(p.ws + OFF_Y) + (size_t)rowb * DM + n0 + wc * 64 + fq * 4;
#pragma unroll
        for (int i = 0; i < 6; ++i)
#pragma unroll
            for (int j = 0; j < 4; ++j) {
                u32x2 w; w[0] = pk2(acc[i][j][0], acc[i][j][1]); w[1] = pk2(acc[i][j][2], acc[i][j][3]);
                *(u32x2*)(dst + (size_t)(i * 16) * DM + j * 16) = w;
            }
    } else {
        u16* actb = (u16*)(p.ws + OFF_ACT);
        const int colb = (n0 >> 1) + wc * 32 + fq * 4;
#pragma unroll
        for (int i = 0; i < 6; ++i)
#pragma unroll
            for (int jp = 0; jp < 2; ++jp) {
                float o[4];
#pragma unroll
                for (int r = 0; r < 4; ++r) { const float g = acc[i][2 * jp][r], u = acc[i][2 * jp + 1][r]; o[r] = g / (1.f + __expf(-g)) * u; }
                u32x2 w; w[0] = pk2(o[0], o[1]); w[1] = pk2(o[2], o[3]);
                *(u32x2*)(actb + tiled_off(rowb + i * 16, colb + jp * 16, FFH)) = w;
            }
    }
}

__device__ __forceinline__ bool tile_order(int r, int total, int nN, int& mt, int& nt) {
    const int nloc = gridDim.x >> 3, xcd = blockIdx.x & 7, li = blockIdx.x >> 3;
    const int L = (r * 8 + xcd) * nloc + li;
    if (L >= total) return false;
    const int band = L / (8 * nN), rem = L - band * 8 * nN;
    nt = rem >> 3; mt = band * 8 + (rem & 7);
    return true;
}
template <int EPI>
__device__ __forceinline__ void gemm_phase(const Params& p, int l, const u16* A, int lda, const u16* Bt, int K, int nN, bool skip_ctx, unsigned char* smem) {
    const int nM = skip_ctx ? 256 : 288;
    const int total = nM * nN;
    for (int r = 0;; ++r) {
        int mt, nt;
        if (!tile_order(r, total, nN, mt, nt)) break;
        if (skip_ctx) mt = (mt >> 4) * 18 + 2 + (mt & 15);
        gemm_tile<EPI>(p, l, A, lda, Bt, K, mt * 128, nt * 128, smem);
    }
}

template <int EPI>
__device__ __forceinline__ void gemm_phase3(const Params& p, int l, const u16* A, int lda, const u16* Bt, int K, int nN, bool skip_ctx, unsigned char* smem) {
    const int nM = skip_ctx ? 176 : 192;
    const int total = nM * nN;
    for (int r = 0;; ++r) {
        int mt, nt;
        if (!tile_order(r, total, nN, mt, nt)) break;
        if (skip_ctx) { const int bb = mt / 11; mt = bb * 12 + 1 + (mt - bb * 11); }
        gemm_tile3<EPI>(p, l, A, lda, Bt, K, mt * 192, nt * 128, smem);
    }
}

typedef __attribute__((address_space(3))) unsigned char lds_byte_t;
template <int OFF> __device__ __forceinline__ void dsr128(bf16x8& d, unsigned addr) { asm volatile("ds_read_b128 %0, %1 offset:%2" : "=v"(d) : "v"(addr), "n"(OFF)); }
template <int N> __device__ __forceinline__ void wait_lgkm_frag(bf16x8& r) { asm volatile("s_waitcnt lgkmcnt(%1)" : "+v"(r) : "n"(N)); }
template <int NI, int NQB, int KC, int I>
__device__ __forceinline__ void pv_frags(bf16x8 (&vb)[3], unsigned va, const bf16x8 (&pf)[NQB], f32x4 (&o)[NQB][NI]) {
    if constexpr (I + 2 < NI) dsr128<((I + 2) * 2 + KC) * 1024>(vb[(I + 2) % 3], va);
    wait_lgkm_frag<((NI - 1 - I) < 2 ? (NI - 1 - I) : 2)>(vb[I % 3]);
    __builtin_amdgcn_sched_barrier(0);
#pragma unroll
    for (int qb = 0; qb < NQB; ++qb) o[qb][I] = __builtin_amdgcn_mfma_f32_16x16x32_bf16(vb[I % 3], pf[qb], o[qb][I], 0, 0, 0);
    __builtin_amdgcn_sched_barrier(0);
    if constexpr (I + 1 < NI) pv_frags<NI, NQB, KC, I + 1>(vb, va, pf, o);
}
template <int NI, int NQB, int KC>
__device__ __forceinline__ void pv_chunk(unsigned va, const bf16x8 (&pf)[NQB], f32x4 (&o)[NQB][NI]) {
    bf16x8 vb[3];
    __builtin_amdgcn_sched_barrier(0);
    dsr128<(0 * 2 + KC) * 1024>(vb[0], va);
    dsr128<(1 * 2 + KC) * 1024>(vb[1], va);
    pv_frags<NI, NQB, KC, 0>(vb, va, pf, o);
}
template <int NDS, int NQB, int F>
__device__ __forceinline__ void s_frags(bf16x8 (&kb)[3], unsigned ka, const bf16x8 (&qf)[NQB][NDS], f32x4 (&s)[4][NQB]) {
    constexpr int NF = 4 * NDS;
    if constexpr (F + 2 < NF) dsr128<(((F + 2) % 4) * NDS + (F + 2) / 4) * 1024>(kb[(F + 2) % 3], ka);
    wait_lgkm_frag<((NF - 1 - F) < 2 ? (NF - 1 - F) : 2)>(kb[F % 3]);
    __builtin_amdgcn_sched_barrier(0);
#pragma unroll
    for (int qb = 0; qb < NQB; ++qb) s[F % 4][qb] = __builtin_amdgcn_mfma_f32_16x16x32_bf16(kb[F % 3], qf[qb][F / 4], s[F % 4][qb], 0, 0, 0);
    __builtin_amdgcn_sched_barrier(0);
    if constexpr (F + 1 < NF) s_frags<NDS, NQB, F + 1>(kb, ka, qf, s);
}
template <int NDS, int NQB, int KC, int F>
__device__ __forceinline__ void sh_frags(bf16x8 (&kb)[3], unsigned ka, const bf16x8 (&qf)[NQB][NDS], f32x4 (&s)[2][NQB]) {
    constexpr int NF = 2 * NDS;
    if constexpr (F + 2 < NF) dsr128<((2 * KC + (F + 2) % 2) * NDS + (F + 2) / 2) * 1024>(kb[(F + 2) % 3], ka);
    wait_lgkm_frag<((NF - 1 - F) < 2 ? (NF - 1 - F) : 2)>(kb[F % 3]);
    __builtin_amdgcn_sched_barrier(0);
#pragma unroll
    for (int qb = 0; qb < NQB; ++qb) s[F % 2][qb] = __builtin_amdgcn_mfma_f32_16x16x32_bf16(kb[F % 3], qf[qb][F / 2], s[F % 2][qb], 0, 0, 0);
    __builtin_amdgcn_sched_barrier(0);
    if constexpr (F + 1 < NF) sh_frags<NDS, NQB, KC, F + 1>(kb, ka, qf, s);
}
template <int NDS, int NQB, int KC>
__device__ __forceinline__ void sh_chunk(unsigned ka, const bf16x8 (&qf)[NQB][NDS], f32x4 (&s)[2][NQB]) {
    bf16x8 kb[3];
    __builtin_amdgcn_sched_barrier(0);
    dsr128<((2 * KC + 0) * NDS + 0) * 1024>(kb[0], ka);
    dsr128<((2 * KC + 1) * NDS + 0) * 1024>(kb[1], ka);
    sh_frags<NDS, NQB, KC, 0>(kb, ka, qf, s);
}
template <int N> __device__ __forceinline__ void wait_vm() { asm volatile("s_waitcnt vmcnt(%0)" :: "n"(N) : "memory"); }

template <int DQK, int DV, int NQB, int MODE, bool HALF = false>
__device__ __forceinline__ void attn_pass(const u16* __restrict__ Qw, int ldq, const u16* __restrict__ Kb, const u16* __restrict__ Vtb,
                                          int ra0, int ra1, int rb0, int rb1, float scale_log2, float sink_log2, int qpos0,
                                          unsigned char* smem, f32x4 (&o)[NQB][DV / 16]) {
    constexpr int NDS = DQK / 32, NI = DV / 16;
    constexpr int KBYTES = 4 * NDS * 1024, VBYTES = NI * 2 * 1024, STG = KBYTES + VBYTES;
    constexpr int NST = (LDS_BYTES / STG) > 4 ? 4 : (LDS_BYTES / STG);
    constexpr int KPW = NDS, VPW = NI / 2, IPT = KPW + VPW;
    static_assert(NST >= 3, "ring too shallow");
    const int tid = opaque_tid(), lane = tid & 63, wid = tid >> 6, fr = lane & 15, fq = lane >> 4;
    bf16x8 qf[NQB][DQK / 32];
#pragma unroll
    for (int qb = 0; qb < NQB; ++qb)
#pragma unroll
        for (int ks = 0; ks < DQK / 32; ++ks) qf[qb][ks] = *(const bf16x8*)(Qw + (size_t)(qb * 16 + fr) * ldq + ks * 32 + fq * 8);
    float m[NQB];
    f32x4 lacc[NQB];
    const bf16x8 ones = {(short)0x3F80, (short)0x3F80, (short)0x3F80, (short)0x3F80, (short)0x3F80, (short)0x3F80, (short)0x3F80, (short)0x3F80};
#pragma unroll
    for (int qb = 0; qb < NQB; ++qb) {
        m[qb] = (MODE == 1) ? sink_log2 : -INFINITY;
        { const float l0 = (MODE == 1) ? 1.f : 0.f; lacc[qb] = (f32x4){l0, l0, l0, l0}; }
#pragma unroll
        for (int i = 0; i < DV / 16; ++i) o[qb][i] = (f32x4){0.f, 0.f, 0.f, 0.f};
    }
    const int nA = ra1 - ra0, ntiles = nA + (rb1 - rb0);
    const unsigned voff = (unsigned)(lane * 16);
    const unsigned char* Kbase = (const unsigned char*)Kb;
    const unsigned char* Vbase = (const unsigned char*)Vtb;
#define A_ISSUE(kt_, st_) do { unsigned char* sb_ = smem + (st_) * STG; \
        const unsigned char* kp_ = Kbase + (size_t)(kt_) * KBYTES + voff; const unsigned char* vp_ = Vbase + (size_t)(kt_) * VBYTES + voff; \
        _Pragma("unroll") for (int kb_ = 0; kb_ < 4 * NDS; ++kb_) GLDS16(kp_ + kb_ * 1024, sb_ + kb_ * 1024); \
        _Pragma("unroll") for (int vb_ = 0; vb_ < 2 * NI; ++vb_) GLDS16(vp_ + vb_ * 1024, sb_ + KBYTES + vb_ * 1024); } while (0)
#define A_TILE(it_) (((it_) < nA) ? (ra0 + (it_)) : (rb0 + (it_) - nA))
    if (wid < NST - 1 && wid < ntiles) A_ISSUE(A_TILE(wid), wid);
    if (wid == 0) wait_vm<0>();
    __builtin_amdgcn_s_barrier();
    asm volatile("" ::: "memory");
    int st = 0, stn = NST - 1;
    for (int it = 0; it < ntiles; ++it) {
        const int kt = A_TILE(it);
        if (((it + 1) & 3) == wid && it + 1 < ntiles) wait_vm<0>();
        __builtin_amdgcn_s_barrier();
        asm volatile("" ::: "memory");
        if (((it + NST - 1) & 3) == wid && it + NST - 1 < ntiles) { A_ISSUE(A_TILE(it + NST - 1), stn); }
        const unsigned char* Ks = smem + st * STG + fr * 64 + fq * 16;
        const unsigned char* Vs = Ks + KBYTES;
        if constexpr (HALF) {
            const unsigned ka = (unsigned)(uintptr_t)(lds_byte_t*)Ks;
            const unsigned va = (unsigned)(uintptr_t)(lds_byte_t*)Vs;
#pragma unroll
            for (int kc = 0; kc < 2; ++kc) {
                f32x4 s[2][NQB];
#pragma unroll
                for (int kl = 0; kl < 2; ++kl)
#pragma unroll
                    for (int qb = 0; qb < NQB; ++qb) s[kl][qb] = (f32x4){0.f, 0.f, 0.f, 0.f};
                if (kc == 0) sh_chunk<NDS, NQB, 0>(ka, qf, s); else sh_chunk<NDS, NQB, 1>(ka, qf, s);
                float mxl[NQB];
                bool need = false;
#pragma unroll
                for (int qb = 0; qb < NQB; ++qb) {
                    float mx = -INFINITY;
#pragma unroll
                    for (int kl = 0; kl < 2; ++kl)
#pragma unroll
                        for (int j = 0; j < 4; ++j) {
                            float v = s[kl][qb][j];
                            if (MODE == 1) {
                                if (kt >= 4) {
                                    const int d = (qpos0 + qb * 16 + fr) - ((kt - 4) * 64 + 32 * kc + fq * 8 + kl * 4 + j);
                                    if (d > 128 || d < -128) v = -1e30f;
                                }
                                s[kl][qb][j] = v;
                            }
                            mx = fmaxf(mx, v);
                        }
                    mxl[qb] = mx;
                    need = need || (mx * scale_log2 > m[qb] + 8.f);
                }
                if (__any(need)) {
#pragma unroll
                    for (int qb = 0; qb < NQB; ++qb) {
                        float mx = mxl[qb];
                        mx = fmaxf(mx, __shfl_xor(mx, 16));
                        mx = fmaxf(mx, __shfl_xor(mx, 32));
                        const float mnew = fmaxf(m[qb], mx * scale_log2);
                        const float alpha = __builtin_amdgcn_exp2f(m[qb] - mnew);
                        m[qb] = mnew;
                        lacc[qb] = lacc[qb] * alpha;
#pragma unroll
                        for (int i = 0; i < DV / 16; ++i) o[qb][i] = o[qb][i] * alpha;
                    }
                }
                bf16x8 pf[NQB];
#pragma unroll
                for (int qb = 0; qb < NQB; ++qb) {
                    const float mq = m[qb];
                    float e[2][4];
#pragma unroll
                    for (int kl = 0; kl < 2; ++kl)
#pragma unroll
                        for (int j = 0; j < 4; ++j) e[kl][j] = __builtin_amdgcn_exp2f(__builtin_fmaf(s[kl][qb][j], scale_log2, -mq));
                    u32x4 cu;
                    cu[0] = pk2(e[0][0], e[0][1]); cu[1] = pk2(e[0][2], e[0][3]); cu[2] = pk2(e[1][0], e[1][1]); cu[3] = pk2(e[1][2], e[1][3]);
                    pf[qb] = __builtin_bit_cast(bf16x8, cu);
                    lacc[qb] = __builtin_amdgcn_mfma_f32_16x16x32_bf16(ones, pf[qb], lacc[qb], 0, 0, 0);
                }
                if (kc == 0) pv_chunk<DV / 16, NQB, 0>(va, pf, o); else pv_chunk<DV / 16, NQB, 1>(va, pf, o);
            }
        } else {
        f32x4 s[4][NQB];
#pragma unroll
        for (int kk = 0; kk < 4; ++kk)
#pragma unroll
            for (int qb = 0; qb < NQB; ++qb) s[kk][qb] = (f32x4){0.f, 0.f, 0.f, 0.f};
        {
            const unsigned ka = (unsigned)(uintptr_t)(lds_byte_t*)Ks;
            bf16x8 kb[3];
            __builtin_amdgcn_sched_barrier(0);
            dsr128<(0 * NDS + 0) * 1024>(kb[0], ka);
            dsr128<(1 * NDS + 0) * 1024>(kb[1], ka);
            s_frags<NDS, NQB, 0>(kb, ka, qf, s);
        }
        float mxl[NQB];
        bool need = false;
#pragma unroll
        for (int qb = 0; qb < NQB; ++qb) {
            float mx = -INFINITY;
#pragma unroll
            for (int kk = 0; kk < 4; ++kk)
#pragma unroll
                for (int j = 0; j < 4; ++j) {
                    float v = s[kk][qb][j];
                    if (MODE == 1) {
                        if (kt >= 4) {
                            const int d = (qpos0 + qb * 16 + fr) - ((kt - 4) * 64 + 32 * (kk >> 1) + fq * 8 + (kk & 1) * 4 + j);
                            if (d > 128 || d < -128) v = -1e30f;
                        }
                        s[kk][qb][j] = v;
                    }
                    mx = fmaxf(mx, v);
                }
            mxl[qb] = mx;
            need = need || (mx * scale_log2 > m[qb] + 8.f);
        }
        if (__any(need)) {
#pragma unroll
            for (int qb = 0; qb < NQB; ++qb) {
                float mx = mxl[qb];
                mx = fmaxf(mx, __shfl_xor(mx, 16));
                mx = fmaxf(mx, __shfl_xor(mx, 32));
                const float mnew = fmaxf(m[qb], mx * scale_log2);
                const float alpha = __builtin_amdgcn_exp2f(m[qb] - mnew);
                m[qb] = mnew;
                lacc[qb] = lacc[qb] * alpha;
#pragma unroll
                for (int i = 0; i < DV / 16; ++i) o[qb][i] = o[qb][i] * alpha;
            }
        }
#pragma unroll
        for (int qb = 0; qb < NQB; ++qb) {
            const float mq = m[qb];
#pragma unroll
            for (int kk = 0; kk < 4; ++kk)
#pragma unroll
                for (int j = 0; j < 4; ++j) s[kk][qb][j] = __builtin_amdgcn_exp2f(__builtin_fmaf(s[kk][qb][j], scale_log2, -mq));
        }
#pragma unroll
        for (int kc = 0; kc < 2; ++kc) {
            bf16x8 pf[NQB];
#pragma unroll
            for (int qb = 0; qb < NQB; ++qb) {
                u32x4 cu;
                cu[0] = pk2(s[2 * kc][qb][0], s[2 * kc][qb][1]); cu[1] = pk2(s[2 * kc][qb][2], s[2 * kc][qb][3]);
                cu[2] = pk2(s[2 * kc + 1][qb][0], s[2 * kc + 1][qb][1]); cu[3] = pk2(s[2 * kc + 1][qb][2], s[2 * kc + 1][qb][3]);
                pf[qb] = __builtin_bit_cast(bf16x8, cu);
                lacc[qb] = __builtin_amdgcn_mfma_f32_16x16x32_bf16(ones, pf[qb], lacc[qb], 0, 0, 0);
            }
            const unsigned va = (unsigned)(uintptr_t)(lds_byte_t*)Vs;
            if (kc == 0) pv_chunk<DV / 16, NQB, 0>(va, pf, o); else pv_chunk<DV / 16, NQB, 1>(va, pf, o);
        }
        }
        st = (st + 1 == NST) ? 0 : st + 1;
        stn = (stn + 1 == NST) ? 0 : stn + 1;
    }
#pragma unroll
    for (int qb = 0; qb < NQB; ++qb) {
        const float inv = 1.f / lacc[qb][0];
#pragma unroll
        for (int i = 0; i < DV / 16; ++i) o[qb][i] = o[qb][i] * inv;
    }
    __syncthreads();
}

template <int NQB, int NI>
__device__ __forceinline__ void store_o(u16* O, int row0, int col0, const f32x4 (&o)[NQB][NI]) {
    const int lane = opaque_tid() & 63, fr = lane & 15, fq = lane >> 4;
#pragma unroll
    for (int qb = 0; qb < NQB; ++qb)
#pragma unroll
        for (int i = 0; i < NI; ++i) {
            uint2 w; w.x = pk2(o[qb][i][0], o[qb][i][1]); w.y = pk2(o[qb][i][2], o[qb][i][3]);
            *(uint2*)(O + tiled_off(row0 + qb * 16 + fr, col0 + i * 16 + fq * 4, DM)) = w;
        }
}

__device__ __forceinline__ void attn_even_phase(const Params& p, int l, unsigned char* smem) {
    const int wid = opaque_tid() >> 6;
    const int e = l >> 1;
    const bool last = (l == 3);
    const int nq = last ? 16 : 18;
    const int nB = NBATCH * 8 * nq;
    unsigned char* ws = p.ws;
    u16* O = (u16*)(ws + OFF_HO);
    (void)nq; (void)nB;
    const int total = last ? 3072 : 3072 + 128 + 256;
    for (int it = blockIdx.x; it < total; it += gridDim.x) {
        bool isB; int qt, h, b;
        if (it < 3072) {
            isB = it < 1024; const int r = isB ? it : it - 1024;
            if (isB) { qt = 1 + (r & 7); h = (r >> 3) & 7; b = r >> 6; } else { qt = 2 + (r & 15); h = (r >> 4) & 7; b = r >> 7; }
        } else {
            const int r2 = it - 3072; isB = r2 < 128; const int r = isB ? r2 : r2 - 128;
            if (isB) { qt = 0; h = r & 7; b = r >> 3; } else { qt = r & 1; h = (r >> 1) & 7; b = r >> 4; }
        }
        if (isB) {
            const int row0 = b * TOK + qt * 256 + wid * 64;
            f32x4 o[4][4];
            const u16* Q = (const u16*)(ws + P_QB) + (size_t)row0 * 768 + h * 96;
            const u16* Kb = (const u16*)(ws + P_KB) + ((size_t)(b * 8 + h) * TOK) * 96;
            const u16* Vt = (const u16*)(ws + P_VBT) + ((size_t)(b * 8 + h) * 64) * TOK;
            attn_pass<96, 64, 4, 0, true>(Q, 768, Kb, Vt, 0, (qt < 1) ? 4 : 36, 0, 0, 0.10206207261596577f * LOG2E, 0.f, 0, smem, o);
            store_o<4, 4>(O, row0, 512 + h * 64, o);
        } else {
            const int row0 = b * TOK + qt * 128 + wid * 32;
            f32x4 o[2][4];
            const int kvh = h >> 2;
            const u16* Q = (const u16*)(ws + P_QA) + (size_t)row0 * 512 + h * 64;
            const u16* Kb = (const u16*)(ws + P_KA) + ((size_t)(b * 2 + kvh) * TOK) * 64;
            const u16* Vt = (const u16*)(ws + P_VAT) + ((size_t)(b * 2 + kvh) * 64) * TOK;
            const float sink = p.ev_sink[e * 8 + h] * LOG2E;
            int rb0 = 0, rb1 = 0, qpos0 = 0;
            if (qt >= 2) {
                const int n = qt - 2;
                rb0 = (n == 0) ? 4 : 2 * n + 2;
                rb1 = (2 * n + 8 > 36) ? 36 : 2 * n + 8;
                qpos0 = n * 128 + wid * 32;
            }
            attn_pass<64, 64, 2, 1>(Q, 512, Kb, Vt, 0, 4, rb0, rb1, 0.125f * LOG2E, sink, qpos0, smem, o);
            store_o<2, 4>(O, row0, h * 64, o);
        }
    }
}

__device__ __forceinline__ void attn_odd_phase(const Params& p, int l, unsigned char* smem) {
    const int tid0 = opaque_tid(); const int lane = tid0 & 63, wid = tid0 >> 6, fr = lane & 15, fq = lane >> 4;
    const int oi = l >> 1;
    const bool last = (l == 3);
    const int nqd = last ? 32 : 36, nqc = last ? 16 : 18;
    const int nD = NBATCH * 4 * nqd, nC = NBATCH * 8 * nqc;
    unsigned char* ws = p.ws;
    u16* O = (u16*)(ws + OFF_HO);
    const float lam = ((const float*)(ws + OFF_LAM))[oi];
    const float post = 1.f - lam_init_of(l);
    (void)nD; (void)nC;
    const int total = last ? 2048 : 2048 + 128 + 128;
    for (int it = blockIdx.x; it < total; it += gridDim.x) {
        bool isD; int qx, h, b;
        if (it < 2048) {
            isD = it < 1024; const int r = isD ? it : it - 1024;
            if (isD) { qx = 2 + (r & 15); h = (r >> 4) & 3; b = r >> 6; } else { qx = 1 + (r & 7); h = (r >> 3) & 7; b = r >> 6; }
        } else {
            const int r2 = it - 2048; isD = r2 < 128; const int r = isD ? r2 : r2 - 128;
            if (isD) { qx = r & 1; h = (r >> 1) & 3; b = r >> 3; } else { qx = 0; h = r & 7; b = r >> 3; }
        }
        if (isD) {
            const int row0 = b * TOK + qx * 128 + wid * 32;
            const int hi = (qx < 2) ? 4 : 36;
            const u16* Vt = (const u16*)(ws + P_VDT) + ((size_t)(b * 4 + h) * 128) * TOK;
            f32x4 o0[2][8], o1[2][8];
            {
                const u16* Q = (const u16*)(ws + P_QD) + (size_t)row0 * 512 + (h * 2) * 64;
                const u16* Kb = (const u16*)(ws + P_KD) + ((size_t)(b * 8 + h * 2) * TOK) * 64;
                attn_pass<64, 128, 2, 0>(Q, 512, Kb, Vt, 0, hi, 0, 0, 0.125f * LOG2E, 0.f, 0, smem, o0);
            }
            {
                const u16* Q = (const u16*)(ws + P_QD) + (size_t)row0 * 512 + (h * 2 + 1) * 64;
                const u16* Kb = (const u16*)(ws + P_KD) + ((size_t)(b * 8 + h * 2 + 1) * TOK) * 64;
                attn_pass<64, 128, 2, 0>(Q, 512, Kb, Vt, 0, hi, 0, 0, 0.125f * LOG2E, 0.f, 0, smem, o1);
            }
            const float* sg = p.od_subln + oi * 128;
#pragma unroll
            for (int qb = 0; qb < 2; ++qb) {
                float ss = 0.f;
#pragma unroll
                for (int i = 0; i < 8; ++i) {
                    o0[qb][i] = o0[qb][i] - o1[qb][i] * lam;
                    ss += o0[qb][i][0] * o0[qb][i][0] + o0[qb][i][1] * o0[qb][i][1] + o0[qb][i][2] * o0[qb][i][2] + o0[qb][i][3] * o0[qb][i][3];
                }
                ss += __shfl_xor(ss, 16);
                ss += __shfl_xor(ss, 32);
                const float rinv = rsqrtf(ss * (1.f / 128.f) + EPS) * post;
#pragma unroll
                for (int i = 0; i < 8; ++i) {
                    const f32x4 g = *(const f32x4*)(sg + i * 16 + fq * 4);
                    o0[qb][i] = o0[qb][i] * rinv * g;
                }
            }
            store_o<2, 8>(O, row0, 512 + h * 128, o0);
        } else {
            const int qt = qx;
            const int row0 = b * TOK + qt * 256 + wid * 64;
            const int kvh = h >> 2;
            const u16* Q = (const u16*)(ws + P_QC) + (size_t)row0 * 512 + h * 64;
            const u16* Kb = (const u16*)(ws + P_KC) + ((size_t)(b * 2 + kvh) * TOK) * 64;
            const u16* Vt = (const u16*)(ws + P_VCT) + ((size_t)(b * 2 + kvh) * 64) * TOK;
            f32x4 o[4][4];
            attn_pass<64, 64, 4, 0>(Q, 512, Kb, Vt, 0, (qt < 1) ? 4 : 36, 0, 0, 0.125f * LOG2E, 0.f, 0, smem, o);
            store_o<4, 4>(O, row0, h * 64, o);
        }
    }
}

#define XB_TMO      128
#define XB_XCNT(j)  (256  + 64 * (j))
#define XB_XSUB(j)  (1280 + 64 * (j))
#define XB_XGEN(j)  (2304 + 64 * (j))
#define XB_TOP      3328
#define XB_TOPGEN   3392
#define XCD_BAR_WORDS 3456
#define XB_SPIN_CAP (1u << 20)
#define LAS __attribute__((address_space(3)))
__device__ __forceinline__ unsigned xb_ld(unsigned* p)              { return __hip_atomic_load(p, __ATOMIC_RELAXED, __HIP_MEMORY_SCOPE_AGENT); }
__device__ __forceinline__ unsigned xb_add(unsigned* p, unsigned v) { return __hip_atomic_fetch_add(p, v, __ATOMIC_RELAXED, __HIP_MEMORY_SCOPE_AGENT); }
__device__ __forceinline__ unsigned xb_xcc_id() { return (unsigned)__builtin_amdgcn_s_getreg((3 << 11) | 20) & 0xFu; }
#define XB_SPIN(cond, bar) do { unsigned _sp = 0; while (cond) { __builtin_amdgcn_s_sleep(1); \
    if ((++_sp & 255u) == 0u) { if (xb_ld(&(bar)[XB_TMO])) break; if (_sp > XB_SPIN_CAP) { atomicAdd(&(bar)[XB_TMO], 1u); break; } } } } while (0)
struct XcdBarrier { unsigned* bar; unsigned x; unsigned nloc, nx; };
__device__ __forceinline__ XcdBarrier xcd_barrier_post(unsigned* bar) {
    XcdBarrier b; b.bar = bar; b.x = xb_xcc_id(); b.nloc = 0u; b.nx = 0u;
    if (threadIdx.x == 0) (void)xb_add(&bar[XB_XCNT(b.x)], 1u);
    return b;
}
__device__ __forceinline__ void xcd_barrier_complete(unsigned* bar, unsigned x, unsigned& nloc, unsigned& nx) {
    const unsigned G = gridDim.x * gridDim.y * gridDim.z;
    unsigned sum, cnt, mine, sp = 0u;
    for (;;) {
        sum = 0u; cnt = 0u; mine = 0u;
#pragma unroll
        for (unsigned j = 0; j < 16; ++j) { const unsigned c = xb_ld(&bar[XB_XCNT(j)]); sum += c; cnt += (c > 0u) ? 1u : 0u; mine = (j == x) ? c : mine; }
        if (sum == G) break;
        __builtin_amdgcn_s_sleep(1);
        if ((++sp & 255u) == 0u) { if (xb_ld(&bar[XB_TMO])) break; if (sp > XB_SPIN_CAP) { atomicAdd(&bar[XB_TMO], 1u); break; } }
    }
    nloc = mine > 0u ? mine : 1u; nx = cnt > 0u ? cnt : 1u;
}
__device__ __forceinline__ void xcd_barrier(XcdBarrier& b) {
    asm volatile("s_waitcnt vmcnt(0)" ::: "memory");
    __syncthreads();
    if (threadIdx.x == 0) {
        unsigned* bar = b.bar;
        __builtin_amdgcn_s_waitcnt(0);
        unsigned nloc = b.nloc, nx = b.nx;
        if (nloc == 0u) { xcd_barrier_complete(bar, b.x, nloc, nx); b.nloc = nloc; b.nx = nx; }
        const unsigned old = xb_add(&bar[XB_XSUB(b.x)], 1u);
        const unsigned gen = old / nloc;
        if (old + 1u == (gen + 1u) * nloc) {
            __builtin_amdgcn_fence(__ATOMIC_RELEASE, "agent");
            asm volatile("s_waitcnt vmcnt(0)" ::: "memory");
            const unsigned og = xb_add(&bar[XB_TOP], 1u);
            const unsigned tg = og / nx;
            if (og + 1u == (tg + 1u) * nx) xb_add(&bar[XB_TOPGEN], 1u);
            else XB_SPIN(xb_ld(&bar[XB_TOPGEN]) == tg, bar);
            __builtin_amdgcn_fence(__ATOMIC_ACQUIRE, "agent");
            xb_add(&bar[XB_XGEN(b.x)], 1u);
            asm volatile("s_waitcnt vmcnt(0)" ::: "memory");
        } else {
            XB_SPIN(xb_ld(&bar[XB_XGEN(b.x)]) == gen, bar);
            __builtin_amdgcn_fence(__ATOMIC_ACQUIRE, "agent");
            asm volatile("s_waitcnt vmcnt(0)" ::: "memory");
        }
    }
    __syncthreads();
}

__global__ void __launch_bounds__(256, 2) mega_fwd(Params p) {
    extern __shared__ __attribute__((aligned(16))) unsigned char smem[];
    cg::grid_group grid = cg::this_grid();
    unsigned char* ws = p.ws;
    const u16* Wb = (const u16*)(ws + OFF_W);
    const u16* HO = (const u16*)(ws + OFF_HO);
    unsigned* bar = (unsigned*)(ws + OFF_BAR);
    XcdBarrier xb = xcd_barrier_post(bar);

    for (int rep = 0; rep < REP_P0; ++rep) { if (rep) grid.sync(); phase0(p, smem); }
    grid.sync();
    rownorm_phase(p, 0, 0);
    xcd_barrier(xb);
#pragma unroll 1
    for (int l = 0; l < 4; ++l) {
        const bool last = (l == 3);
        if ((l & 1) == 0) {
            const int e = l >> 1;
            for (int rep = 0; rep < REP_GEMM; ++rep) { if (rep) xcd_barrier(xb); gemm_phase<EPI_EIN>(p, l, HO, DM, Wb + W_EIN + (size_t)e * 1280 * 1024, 1024, 10, false, smem); }
            xcd_barrier(xb);
            {
                const int tq = 288 * 6, tkv = 288 * 8;
                for (int rep = 0; rep < REP_GEMM; ++rep) { if (rep) xcd_barrier(xb);
                for (int r = 0;; ++r) {
                    int mt, nt;
                    if (!tile_order(r, tq, 6, mt, nt)) break;
                    gemm_tile<EPI_UQ>(p, l, (const u16*)(ws + P_CQ), 256, Wb + W_UQ + (size_t)e * 768 * 256, 256, mt * 128, nt * 128, smem);
                }
                for (int r = 0;; ++r) {
                    int mt, nt;
                    if (!tile_order(r, tkv, 8, mt, nt)) break;
                    gemm_tile<EPI_UKV>(p, l, (const u16*)(ws + P_CKV), 128, Wb + W_UKV + (size_t)e * 1024 * 128, 128, mt * 128, nt * 128, smem);
                }
                }
            }
            xcd_barrier(xb);
            for (int rep = 0; rep < REP_ATTN; ++rep) { if (rep) xcd_barrier(xb); attn_even_phase(p, l, smem); }
            xcd_barrier(xb);
            for (int rep = 0; rep < REP_GEMM; ++rep) { if (rep) xcd_barrier(xb); gemm_phase3<EPI_Y>(p, l, HO, DM, Wb + W_EOUT + (size_t)e * 1024 * 1024, 1024, 8, last, smem); }
        } else {
            const int o = l >> 1;
            for (int rep = 0; rep < REP_GEMM; ++rep) { if (rep) xcd_barrier(xb); gemm_phase<EPI_OIN>(p, l, HO, DM, Wb + W_OIN + (size_t)o * 2304 * 1024, 1024, 18, false, smem); }
            xcd_barrier(xb);
            for (int rep = 0; rep < REP_ATTN; ++rep) { if (rep) xcd_barrier(xb); attn_odd_phase(p, l, smem); }
            xcd_barrier(xb);
            for (int rep = 0; rep < REP_GEMM; ++rep) { if (rep) xcd_barrier(xb); gemm_phase3<EPI_Y>(p, l, HO, DM, Wb + W_OOUT + (size_t)o * 1024 * 1024, 1024, 8, last, smem); }
        }
        xcd_barrier(xb);
        rownorm_phase(p, 1, l);
        xcd_barrier(xb);
        for (int rep = 0; rep < REP_GEMM; ++rep) { if (rep) xcd_barrier(xb); gemm_phase3<EPI_FFN1>(p, l, HO, DM, Wb + W_FFN1 + (size_t)l * 5632 * 1024, 1024, 44, last, smem); }
        xcd_barrier(xb);
        for (int rep = 0; rep < REP_GEMM; ++rep) { if (rep) xcd_barrier(xb); gemm_phase3<EPI_Y>(p, l, (const u16*)(ws + OFF_ACT), FFH, Wb + W_FFN2 + (size_t)l * 1024 * 2816, 2816, 8, last, smem); }
        xcd_barrier(xb);
        rownorm_phase(p, 2, l);
        if (!last) xcd_barrier(xb);
    }
}

extern "C" void kernel_launch(void* const* d_in, const int* in_sizes, int n_in, void* d_out, int out_size, void* d_ws, size_t ws_size, hipStream_t stream) {
    static int grid_blocks = 0;
    if (grid_blocks == 0) {
        if (n_in != 21 || ws_size < WS_TOTAL) { fprintf(stderr, "kernel_launch: unexpected n_in %d or ws_size %zu (< %zu)\n", n_in, ws_size, (size_t)WS_TOTAL); grid_blocks = -1; return; }
        int dev = 0, cus = 0, per_cu = 0;
        hipGetDevice(&dev);
        hipDeviceGetAttribute(&cus, hipDeviceAttributeMultiprocessorCount, dev);
        if (hipFuncSetAttribute((const void*)mega_fwd, hipFuncAttributeMaxDynamicSharedMemorySize, LDS_BYTES) != hipSuccess) { fprintf(stderr, "kernel_launch: hipFuncSetAttribute failed\n"); grid_blocks = -1; return; }
        if (hipOccupancyMaxActiveBlocksPerMultiprocessor(&per_cu, (const void*)mega_fwd, 256, LDS_BYTES) != hipSuccess || per_cu < 1) { fprintf(stderr, "kernel_launch: occupancy query failed (%d)\n", per_cu); per_cu = 1; (void)hipGetLastError(); }
        if (per_cu > 2) per_cu = 2;
        grid_blocks = cus * per_cu;
    }
    if (grid_blocks < 0) return;
    Params p{};
    p.x = (const float*)d_in[0]; p.c = (const float*)d_in[1]; p.ctx = (const float*)d_in[2]; p.c_ctx = (const float*)d_in[3];
    p.ada_w = (const float*)d_in[4]; p.ada_b = (const float*)d_in[5]; p.norm_g = (const float*)d_in[6];
    p.ffn_w_in = (const float*)d_in[7]; p.ffn_w_out = (const float*)d_in[8];
    p.ev_w_in = (const float*)d_in[9]; p.ev_sink = (const float*)d_in[10]; p.ev_q_norm = (const float*)d_in[11]; p.ev_w_uq = (const float*)d_in[12];
    p.ev_kv_norm = (const float*)d_in[13]; p.ev_w_ukv = (const float*)d_in[14]; p.ev_w_out = (const float*)d_in[15];
    p.od_w_in = (const float*)d_in[16]; p.od_qk_norm = (const float*)d_in[17]; p.od_lambda = (const float*)d_in[18]; p.od_subln = (const float*)d_in[19]; p.od_w_out = (const float*)d_in[20];
    p.out = (float*)d_out; p.ws = (unsigned char*)d_ws;
    if (hipMemsetAsync((unsigned char*)d_ws + OFF_BAR, 0, 16384, stream) != hipSuccess) { fprintf(stderr, "kernel_launch: memset of barrier words failed\n"); return; }
    void* args[] = {&p};
    hipError_t e = hipLaunchCooperativeKernel((const void*)mega_fwd, dim3(grid_blocks), dim3(256), args, LDS_BYTES, stream);
    if (e != hipSuccess) fprintf(stderr, "cooperative launch failed: %s (grid %d)\n", hipGetErrorString(e), grid_blocks);
}
```
